# Optimizing an MI355X kernel written in HIP

```python
import jax, jax.numpy as jnp
from jax import lax
import numpy as np

D_MODEL = 1024
BATCH = 8
SEQ = 2048
DEPTH = 4

CHUNK = 64
Q_BLOCK = 128
EPS = 1e-6

A_HEADS = 8
A_HEAD_DIM = 64
A_WIDTH = A_HEADS * A_HEAD_DIM
KV_LATENT = 128
IDX_HEADS = 8
IDX_DIM = 64
TOPK_MAX = 256

B_WIDTH = D_MODEL - A_WIDTH
B_GROUPS = 4
B_GROUP_DIM = B_WIDTH // B_GROUPS
SGU_CHUNK = 128

POOL_WINDOWS = (2, 4, 8, 16)
C_GROUPS = len(POOL_WINDOWS)
C_GROUP_DIM = D_MODEL // C_GROUPS

N_GROUPS = 4
EXPERTS_PER_GROUP = 8
N_EXPERTS = N_GROUPS * EXPERTS_PER_GROUP
TOP_K_IN_GROUP = 2
D_EXPERT = 256

IN_SIZES = (A_WIDTH, KV_LATENT, IDX_HEADS * IDX_DIM, IDX_DIM, IDX_HEADS, B_WIDTH, B_WIDTH)
D_IN = sum(IN_SIZES)
IN_OFFSETS = tuple(int(o) for o in np.cumsum(IN_SIZES)[:-1])

N_EVEN = (DEPTH + 1) // 2
N_ODD = DEPTH // 2

kernel_name = "hybrid_dsa_sgu_pool_hmoe_trunk"


def rmsnorm(x, g):
    xf = x.astype(jnp.float32)
    y = xf * lax.rsqrt(jnp.mean(xf * xf, axis=-1, keepdims=True) + EPS)
    return (y * g.astype(jnp.float32)).astype(x.dtype)


def layernorm(x, g):
    xf = x.astype(jnp.float32)
    mu = jnp.mean(xf, axis=-1, keepdims=True)
    var = jnp.mean(jnp.square(xf - mu), axis=-1, keepdims=True)
    return ((xf - mu) * lax.rsqrt(var + EPS) * g.astype(jnp.float32)).astype(x.dtype)


def modulate(h, shift, scale):
    return h * (1 + scale[:, None, :]) + shift[:, None, :]


def alibi_slopes(n):
    return jnp.asarray(np.array([2.0 ** (-8.0 * (i + 1) / n) for i in range(n)], dtype=np.float32))


def dsa_attention(q, k, v, q_idx, k_idx, w_idx):
    B, S = q.shape[0], q.shape[1]
    topk = min(TOPK_MAX, S // 4)
    nb = S // Q_BLOCK
    slopes = alibi_slopes(A_HEADS)
    key_pos = jnp.arange(S)
    kv = jnp.concatenate([k, v], axis=-1)

    def to_blocks(a):
        return jnp.moveaxis(a.reshape((B, nb, Q_BLOCK) + a.shape[2:]), 1, 0)

    def block(args):
        qb, qib, wib, qpos = args
        logits = jnp.einsum('bqhd,bsd->bqhs', qib, k_idx) * (IDX_DIM ** -0.5)
        score = jnp.einsum('bqhs,bqh->bqs', jax.nn.relu(logits), wib).astype(jnp.float32)
        visible = (key_pos[None, :] // CHUNK) <= (qpos[:, None] // CHUNK)
        score = jnp.where(visible[None], score, -jnp.inf)
        _, idx = lax.top_k(score, topk)
        valid = (idx // CHUNK) <= (qpos[None, :, None] // CHUNK)
        kv_sel = jax.vmap(lambda kk, ii: kk[ii])(kv, idx)
        k_sel, v_sel = jnp.split(kv_sel, 2, axis=-1)
        att = jnp.einsum('bqhd,bqkd->bqhk', qb, k_sel).astype(jnp.float32) * (A_HEAD_DIM ** -0.5)
        dist = jnp.abs(qpos[None, :, None] - idx).astype(jnp.float32)
        att = att - slopes[None, None, :, None] * dist[:, :, None, :]
        att = jnp.where(valid[:, :, None, :], att, -jnp.inf)
        p = jax.nn.softmax(att, axis=-1).astype(v.dtype)
        return jnp.einsum('bqhk,bqkd->bqhd', p, v_sel)

    out = lax.map(block, (to_blocks(q), to_blocks(q_idx), to_blocks(w_idx),
                          jnp.arange(S).reshape(nb, Q_BLOCK)))
    return jnp.moveaxis(out, 0, 1).reshape(B, S, A_WIDTH)


def spatial_gating(u, v, ln_g, w_s, b_s):
    B, S, _ = u.shape
    u = jax.nn.gelu(u)
    v = layernorm(jax.nn.gelu(v), ln_g)
    nc = S // SGU_CHUNK
    vg = v.reshape(B, nc, SGU_CHUNK, B_GROUPS, B_GROUP_DIM)
    pos = jnp.arange(SGU_CHUNK)
    mask = (pos[None, :] // CHUNK) <= (pos[:, None] // CHUNK)
    w = jnp.where(mask[None], w_s, jnp.zeros_like(w_s))
    mixed = jnp.einsum('gij,bnjgc->bnigc', w, vg) + b_s.T[None, None, :, :, None]
    return u * mixed.reshape(B, S, B_WIDTH)


def hybrid_ab(h, w_in, kv_norm, w_kv_up, sgu_norm, w_s, b_s, w_o):
    B, S, _ = h.shape
    proj = h @ w_in
    q, kv_lat, q_idx, k_idx, w_idx, u, v = jnp.split(proj, IN_OFFSETS, axis=-1)
    kv = rmsnorm(kv_lat, kv_norm) @ w_kv_up
    k, v_att = jnp.split(kv, 2, axis=-1)
    a_out = dsa_attention(q.reshape(B, S, A_HEADS, A_HEAD_DIM), k, v_att,
                          q_idx.reshape(B, S, IDX_HEADS, IDX_DIM), k_idx,
                          w_idx * (IDX_HEADS ** -0.5))
    b_out = spatial_gating(u, v, sgu_norm, w_s, b_s)
    return jnp.concatenate([a_out, b_out], axis=-1) @ w_o


def multiscale_pool(h, w_pool, scale):
    B, S, D = h.shape
    hf = h.astype(jnp.float32).reshape(B, S, C_GROUPS, C_GROUP_DIM)
    cs = jnp.concatenate([jnp.zeros((B, 1, C_GROUPS, C_GROUP_DIM), jnp.float32),
                          jnp.cumsum(hf, axis=1)], axis=1)
    t = jnp.arange(S)
    pooled = []
    for g, win in enumerate(POOL_WINDOWS):
        start = jnp.maximum(t + 1 - win, 0)
        cnt = (t + 1 - start).astype(jnp.float32)
        pooled.append((cs[:, 1:, g] - cs[:, start, g]) / cnt[None, :, None])
    y = (jnp.stack(pooled, axis=2) - hf).astype(h.dtype)
    y = jnp.einsum('bsgc,gce->bsge', y, w_pool).reshape(B, S, D)
    return y * scale


def hier_moe(h, w_gr, b_gr, w_er, b_er, w_gate, w_up, w_down):
    def per_seq(t):
        S = t.shape[0]
        g_logits = (t @ w_gr).astype(jnp.float32) + b_gr.astype(jnp.float32)
        g_prob = jax.nn.softmax(g_logits, axis=-1)
        g_sel = jnp.argmax(g_logits, axis=-1)
        p_g = jnp.take_along_axis(g_prob, g_sel[:, None], axis=1)
        e_logits = ((t @ w_er).astype(jnp.float32) + b_er.astype(jnp.float32)).reshape(S, N_GROUPS, EXPERTS_PER_GROUP)
        e_in_group = jnp.take_along_axis(e_logits, g_sel[:, None, None], axis=1)[:, 0]
        top_val, top_idx = lax.top_k(e_in_group, TOP_K_IN_GROUP)
        gate = p_g * jax.nn.softmax(top_val, axis=-1)
        expert_id = g_sel[:, None] * EXPERTS_PER_GROUP + top_idx
        combine = jnp.sum(jax.nn.one_hot(expert_id, N_EXPERTS, dtype=jnp.float32) * gate[..., None], axis=1)
        hg = jnp.einsum('sd,edf->sef', t, w_gate)
        hu = jnp.einsum('sd,edf->sef', t, w_up)
        act = jax.nn.silu(hg) * hu * combine[:, :, None].astype(t.dtype)
        return jnp.einsum('sef,efd->sd', act, w_down)
    return lax.map(per_seq, h)


def setup_inputs(seed: int = 0) -> dict:
    key = jax.random.key(seed)
    ks = iter(jax.random.split(key, 32))
    f32 = jnp.float32
    D = D_MODEL

    def nrm(shape, scale):
        return jax.random.normal(next(ks), shape, f32) * scale

    def gain(shape):
        return 1.0 + 0.02 * jax.random.normal(next(ks), shape, f32)

    return {
        "x": nrm((BATCH, SEQ, D), 1.0),
        "c": nrm((BATCH, D), 1.0),
        "w_mod": nrm((DEPTH, D, 6 * D), 0.5 * D ** -0.5),
        "b_mod": nrm((DEPTH, 6 * D), 0.02),
        "norm_mix": gain((DEPTH, D)),
        "norm_ffn": gain((DEPTH, D)),
        "w_in": nrm((N_EVEN, D, D_IN), D ** -0.5),
        "kv_norm": gain((N_EVEN, KV_LATENT)),
        "w_kv_up": nrm((N_EVEN, KV_LATENT, 2 * A_HEAD_DIM), KV_LATENT ** -0.5),
        "sgu_norm": gain((N_EVEN, B_WIDTH)),
        "w_s": nrm((N_EVEN, B_GROUPS, SGU_CHUNK, SGU_CHUNK), SGU_CHUNK ** -0.5),
        "b_s": gain((N_EVEN, B_GROUPS, SGU_CHUNK)),
        "w_o": nrm((N_EVEN, D, D), D ** -0.5),
        "w_pool": nrm((N_ODD, C_GROUPS, C_GROUP_DIM, C_GROUP_DIM), C_GROUP_DIM ** -0.5),
        "pool_scale": gain((N_ODD, D)),
        "w_gr": nrm((DEPTH, D, N_GROUPS), D ** -0.5),
        "b_gr": nrm((DEPTH, N_GROUPS), 0.01),
        "w_er": nrm((DEPTH, D, N_EXPERTS), D ** -0.5),
        "b_er": nrm((DEPTH, N_EXPERTS), 0.01),
        "w_gate": nrm((DEPTH, N_EXPERTS, D, D_EXPERT), D ** -0.5),
        "w_up": nrm((DEPTH, N_EXPERTS, D, D_EXPERT), D ** -0.5),
        "w_down": nrm((DEPTH, N_EXPERTS, D_EXPERT, D), D_EXPERT ** -0.5),
        "norm_out": gain((D,)),
    }


def reference(x, c, w_mod, b_mod, norm_mix, norm_ffn, w_in, kv_norm, w_kv_up, sgu_norm,
              w_s, b_s, w_o, w_pool, pool_scale, w_gr, b_gr, w_er, b_er,
              w_gate, w_up, w_down, norm_out):
    cs = jax.nn.silu(c)
    for i in range(DEPTH):
        mod = cs @ w_mod[i] + b_mod[i]
        sh_m, sc_m, g_m, sh_f, sc_f, g_f = jnp.split(mod, 6, axis=-1)
        h = modulate(rmsnorm(x, norm_mix[i]), sh_m, sc_m)
        j = i // 2
        if i % 2 == 0:
            y = hybrid_ab(h, w_in[j], kv_norm[j], w_kv_up[j], sgu_norm[j], w_s[j], b_s[j], w_o[j])
        else:
            y = multiscale_pool(h, w_pool[j], pool_scale[j])
        x = x + g_m[:, None, :] * y
        h = modulate(rmsnorm(x, norm_ffn[i]), sh_f, sc_f)
        x = x + g_f[:, None, :] * hier_moe(h, w_gr[i], b_gr[i], w_er[i], b_er[i],
                                           w_gate[i], w_up[i], w_down[i])
    return rmsnorm(x, norm_out)
```

```cpp
#include <hip/hip_runtime.h>
#include <cstdio>
#include <cstdint>

#define LAS __attribute__((address_space(3)))
#define DI __device__ __forceinline__
typedef unsigned short bf16_t;
typedef short bf16x8 __attribute__((ext_vector_type(8)));
typedef float f32x4 __attribute__((ext_vector_type(4)));
typedef float f32x2 __attribute__((ext_vector_type(2)));
typedef unsigned u32x4 __attribute__((ext_vector_type(4)));
typedef unsigned u32x2 __attribute__((ext_vector_type(2)));
typedef short s16x4 __attribute__((ext_vector_type(4)));
typedef __bf16 bfv2 __attribute__((ext_vector_type(2)));
typedef _Float16 h16x4 __attribute__((ext_vector_type(4)));
typedef _Float16 h16x8 __attribute__((ext_vector_type(8)));
typedef _Float16 xh_t;

constexpr int NB = 8, SEQ = 2048, DM = 1024, MTOK = NB * SEQ;
constexpr int DIN = 2248, DINP = 2304;
constexpr int PC_Q = 0, PC_QI = 512, PC_U = 1024, PC_V = 1536, PC_KVL = 2048, PC_KI = 2176, PC_WI = 2240;
constexpr int NEXP = 32, CAP = 16384, MAXPOS = 40960;
constexpr float EPS = 1e-6f;
constexpr float LOG2E = 1.4426950408889634f;

constexpr size_t MiB = 1u << 20;
constexpr size_t WS_CTL = 0, CTL_BYTES = 704 * 1024;
constexpr size_t WS_MOD = 1 * MiB;
constexpr size_t WS_WR = 2 * MiB;
constexpr size_t WS_WKV = 3 * MiB;
constexpr size_t WS_WS = 4 * MiB;
constexpr size_t WS_WPOOL = 5 * MiB;
constexpr size_t WS_WIN = 6 * MiB;
constexpr size_t WS_WO = 15 * MiB;
constexpr size_t WS_TOKMETA = 19 * MiB;
constexpr size_t WS_RSTD = 19 * MiB + 256 * 1024;
constexpr size_t WS_TOKIDX = 20 * MiB;
constexpr size_t WS_GATES = 22 * MiB;
constexpr size_t WS_K = 24 * MiB;
constexpr size_t WS_VT = 26 * MiB;
constexpr size_t WS_WGU = 28 * MiB;
constexpr size_t WS_WDN = 156 * MiB;
constexpr size_t WS_X0 = 220 * MiB, WS_X1 = 284 * MiB;
constexpr size_t WS_H = 348 * MiB;
constexpr size_t WS_PROJ = 380 * MiB;
constexpr size_t WS_CAT = 452 * MiB;
constexpr size_t WS_YBUF = 380 * MiB;
constexpr size_t WS_ACT = 380 * MiB;
constexpr size_t WS_YMOE = 400 * MiB;
constexpr size_t WS_END = 484 * MiB;
constexpr int CW_BAR = 4096;
constexpr int CW_CNT = 8192;
constexpr int CW_TMO = 64;
constexpr int CW_MTC = 16384;
constexpr int CW_WPC = 61440;
constexpr int CW_A45Q = 80000;
constexpr int CW_PNL = 84000;
constexpr int CW_XP = 92192;
constexpr int CW_NR = 108576;
constexpr int CW_PL = 141344;
constexpr int CW_CVQ = 12288;

constexpr int STAGE_REGION = 131072;
constexpr int SC_PITCH = 2052;
constexpr int IDX_OFF = 16 * SC_PITCH * 4;
constexpr int MISC_OFF = 139776;
constexpr int TAB_OFF = MISC_OFF + 256;
constexpr int KSTG_OFF = 143360;
constexpr int QSLOT_OFF = KSTG_OFF + 8 * 2048;
constexpr int LDS_BYTES = 163840;

#ifndef PROBE_MASK
#define PROBE_MASK 0
#endif
#define LDS_WAIT() asm volatile("s_waitcnt lgkmcnt(0)" ::: "memory")
DI int opaque_tid() { int t = threadIdx.x; asm volatile("" : "+v"(t)); return t; }
DI unsigned char* opaque_ws(unsigned char* p) { size_t z = 0; asm volatile("" : "+s"(z)); return p + z; }

DI unsigned pk2(float a, float b) { f32x2 v = {a, b}; bfv2 r = __builtin_convertvector(v, bfv2); return __builtin_bit_cast(unsigned, r); }
DI f32x4 ldx4(const xh_t* p) { return __builtin_convertvector(*(const h16x4*)p, f32x4); }
DI void stx4(xh_t* p, f32x4 v) { *(h16x4*)p = __builtin_convertvector(v, h16x4); }
DI float bflo(unsigned u) { return __uint_as_float(u << 16); }
DI float bfhi(unsigned u) { return __uint_as_float(u & 0xffff0000u); }
DI float shx(float v, int o, int lane) { return __int_as_float(__builtin_amdgcn_ds_bpermute((lane ^ o) << 2, __float_as_int(v))); }
DI float wave_sum(float v, int lane) {
#pragma unroll
    for (int o = 1; o < 64; o <<= 1) v += shx(v, o, lane);
    return v;
}
DI float gelu_tanh(float x) {
    const float t = x * x;
    const float inner = x * (0.7978845608f + 0.0356774081f * t);
    const float e = __builtin_amdgcn_exp2f(-2.8853900818f * inner);
    return x * __builtin_amdgcn_rcpf(1.0f + e);
}
DI float silu_f(float x) { return x * __builtin_amdgcn_rcpf(1.0f + __builtin_amdgcn_exp2f(-LOG2E * x)); }

#define XB_TMO      128
#define XB_XCNT(j)  (256  + 64 * (j))
#define XB_XSUB(j)  (1280 + 64 * (j))
#define XB_XGEN(j)  (2304 + 64 * (j))
#define XB_TOP      3328
#define XB_TOPGEN   3392
#define XCD_BAR_WORDS 3456
#define XB_SPIN_CAP (1u << 18)

__device__ __forceinline__ unsigned xb_ld(unsigned* p)              { return __hip_atomic_load(p, __ATOMIC_RELAXED, __HIP_MEMORY_SCOPE_AGENT); }
__device__ __forceinline__ unsigned xb_add(unsigned* p, unsigned v) { return __hip_atomic_fetch_add(p, v, __ATOMIC_RELAXED, __HIP_MEMORY_SCOPE_AGENT); }
__device__ __forceinline__ unsigned xb_xcc_id() { return (unsigned)__builtin_amdgcn_s_getreg((3 << 11) | 20) & 0xFu; }
#define XB_SPIN(cond, bar) do { unsigned _sp = 0; while (cond) { __builtin_amdgcn_s_sleep(1); \
    if ((++_sp & 255u) == 0u) { if (xb_ld(&(bar)[XB_TMO])) break; if (_sp > XB_SPIN_CAP) { atomicAdd(&(bar)[XB_TMO], 1u); break; } } } } while (0)

struct XcdBarrier {
    unsigned* bar; unsigned x;
    volatile LAS unsigned* st;
};
__device__ __forceinline__ XcdBarrier xcd_barrier_post(unsigned* bar, volatile LAS unsigned* st) {
    XcdBarrier b; b.bar = bar; b.x = xb_xcc_id(); b.st = st;
    if (threadIdx.x == 0) (void)xb_add(&bar[XB_XCNT(b.x)], 1u);
    return b;
}
__device__ __forceinline__ void xcd_barrier_complete(unsigned* bar, unsigned x, unsigned& nloc, unsigned& nx) {
    const unsigned G = gridDim.x * gridDim.y * gridDim.z;
    unsigned sum, cnt, mine, sp = 0u;
    for (;;) {
        sum = 0u; cnt = 0u; mine = 0u;
#pragma unroll
        for (unsigned j = 0; j < 16; ++j) { const unsigned c = xb_ld(&bar[XB_XCNT(j)]); sum += c; cnt += (c > 0u) ? 1u : 0u; mine = (j == x) ? c : mine; }
        if (sum == G) break;
        __builtin_amdgcn_s_sleep(1);
        if ((++sp & 255u) == 0u) { if (xb_ld(&bar[XB_TMO])) break; if (sp > XB_SPIN_CAP) { atomicAdd(&bar[XB_TMO], 1u); break; } }
    }
    nloc = mine > 0u ? mine : 1u; nx = cnt > 0u ? cnt : 1u;
}
__device__ __forceinline__ void xcd_barrier(const XcdBarrier& b) {
    asm volatile("s_waitcnt vmcnt(0)" ::: "memory");
    __syncthreads();
    if (threadIdx.x == 0) {
        size_t bz = 0; unsigned bx = b.x;
        asm volatile("" : "+s"(bz), "+s"(bx)); unsigned* bar = b.bar + bz;
        __builtin_amdgcn_s_waitcnt(0);
        unsigned nloc = b.st[0], nx = b.st[1];
        if (nloc == 0u) { xcd_barrier_complete(bar, bx, nloc, nx); b.st[0] = nloc; b.st[1] = nx; }
        const unsigned old = xb_add(&bar[XB_XSUB(bx)], 1u);
        const unsigned gen = old / nloc;
        if (old + 1u == (gen + 1u) * nloc) {
            __builtin_amdgcn_fence(__ATOMIC_RELEASE, "agent");
            asm volatile("s_waitcnt vmcnt(0)" ::: "memory");
            const unsigned og = xb_add(&bar[XB_TOP], 1u);
            const unsigned tg = og / nx;
            if (og + 1u == (tg + 1u) * nx) xb_add(&bar[XB_TOPGEN], 1u);
            else XB_SPIN(xb_ld(&bar[XB_TOPGEN]) == tg, bar);
            __builtin_amdgcn_fence(__ATOMIC_ACQUIRE, "agent");
            xb_add(&bar[XB_XGEN(bx)], 1u);
            asm volatile("s_waitcnt vmcnt(0)" ::: "memory");
        } else {
            XB_SPIN(xb_ld(&bar[XB_XGEN(bx)]) == gen, bar);
            __builtin_amdgcn_fence(__ATOMIC_ACQUIRE, "agent");
            asm volatile("s_waitcnt vmcnt(0)" ::: "memory");
        }
    }
    __syncthreads();
}

namespace pg8 {
constexpr int BM = 256, BK = 64, HALF = 128, HTB = HALF * BK * 2, NXCD = 8, WGM = 8;
DI int lds_byte(int r, int c) { const int st = (r >> 4) * 2 + (c >> 5), rr = r & 15, cc = c & 31, ob = rr * 64 + cc * 2; return st * 1024 + (ob ^ (((ob >> 9) & 1) << 5)); }
DI void stage_rc(int b, int& R, int& C) { const int st = b / 1024, sb = b % 1024, swz = sb ^ (((sb >> 9) & 1) << 5); R = (st >> 1) * 16 + swz / 64; C = (st & 1) * 32 + (swz % 64) / 2; }
DI int perm32(int rho) { const int n = rho >> 4, i = rho & 15; return 8 * (i >> 2) + 4 * n + (i & 3); }

struct Unit { int pm, pn, aux; };

struct StaticSched {
    int nM, nN, nwg, G, c;
    const char* A; const char* B; size_t a_tile, a_pn, b_tile; unsigned lda2;
    DI void init(int nM_, int nN_, int G_, int c_) { nM = nM_; nN = nN_; nwg = nM * nN; G = G_; c = c_; }
    DI bool next(int i, Unit& u) const {
        const long L = (long)i * G + c; if (L >= nwg) return false;
        int wgid = (int)L; { const int q = nwg / NXCD, r = nwg % NXCD, xcd = wgid % NXCD, off = wgid / NXCD; wgid = (xcd < r ? xcd * (q + 1) : r * (q + 1) + (xcd - r) * q) + off; }
        const int nig = WGM * nN, gid = wgid / nig, fm = gid * WGM, gsz = (nM - fm) < WGM ? (nM - fm) : WGM;
        u.pm = fm + ((wgid % nig) % gsz); u.pn = (wgid % nig) / gsz; u.aux = 0; return true;
    }
    DI const char* a_ptr(const Unit& u) const { return A + (size_t)u.pm * a_tile + (size_t)u.pn * a_pn; }
    DI const char* b_ptr(const Unit& u) const { return B + (size_t)u.pn * b_tile; }
    DI unsigned a_rowoff(const Unit&, int r) const { return (unsigned)r * lda2; }
    DI void a_ready(const Unit&, int, unsigned) const {}
    DI unsigned early(const Unit&, int) const { return 0u; }
    DI void done(const Unit&, int) const {}
};

struct WinSched : StaticSched {
    unsigned* wpc;
    DI void done(const Unit& u, int tid) const {
        if (u.pn >= 4 && u.pn < 8) { asm volatile("s_waitcnt vmcnt(0)" ::: "memory");
            if ((tid & 63) == 0) (void)__hip_atomic_fetch_add(wpc + 64 * u.pm, 1u, __ATOMIC_RELAXED, __HIP_MEMORY_SCOPE_AGENT); }
    }
};
struct XpSched : StaticSched {
    unsigned* xp;
    DI void done(const Unit& u, int tid) const {
        asm volatile("s_waitcnt vmcnt(0)" ::: "memory");
        if ((tid & 63) == 0) (void)__hip_atomic_fetch_add(xp + 64 * u.pm, 1u, __ATOMIC_RELAXED, __HIP_MEMORY_SCOPE_AGENT); }
};
struct PoolSched : XpSched {
    unsigned* plc; unsigned* tmo;
    DI void a_ready(const Unit& u, int tid, unsigned) const {
        if (tid < 64) { const int ch = 4 * u.pm + (tid & 7); const bool need = (tid < 4) || (tid == 4 && ch < MTOK / 64 && (ch & 31) != 0);
            unsigned spins = 0;
            for (;;) { const unsigned v = need ? __hip_atomic_load(plc + 64 * ch, __ATOMIC_RELAXED, __HIP_MEMORY_SCOPE_AGENT) : 8u;
                if (__ballot(v < 8u) == 0ull) break;
                __builtin_amdgcn_s_sleep(2);
                if (++spins > (1u << 20)) { if (tid == 0) __hip_atomic_store(tmo, 1u, __ATOMIC_RELAXED, __HIP_MEMORY_SCOPE_AGENT); break; } }
            __builtin_amdgcn_fence(__ATOMIC_ACQUIRE, "agent");
            asm volatile("s_waitcnt vmcnt(0)" ::: "memory"); }
        asm volatile("" ::: "memory"); __builtin_amdgcn_s_barrier(); asm volatile("" ::: "memory");
    }
};
struct WoSched : XpSched {
    unsigned* pnl; unsigned* tmo;
    DI void a_ready(const Unit& u, int tid, unsigned) const {
        if (tid < 64) { unsigned spins = 0;
            while ((unsigned)__builtin_amdgcn_readfirstlane((int)__hip_atomic_load(pnl + 64 * u.pm, __ATOMIC_RELAXED, __HIP_MEMORY_SCOPE_AGENT)) < 16u) {
                __builtin_amdgcn_s_sleep(2);
                if (++spins > (1u << 20)) { if (tid == 0) __hip_atomic_store(tmo, 1u, __ATOMIC_RELAXED, __HIP_MEMORY_SCOPE_AGENT); break; } }
            __builtin_amdgcn_fence(__ATOMIC_ACQUIRE, "agent");
            asm volatile("s_waitcnt vmcnt(0)" ::: "memory"); }
        asm volatile("" ::: "memory"); __builtin_amdgcn_s_barrier(); asm volatile("" ::: "memory");
    }
};
#define PG8_SA(b, h) (((b) * 2 + (h)) * HTB)
#define PG8_SB(b, h) ((4 + (b) * 2 + (h)) * HTB)
#define PG8_STAGE(bufoff, gbase, voff) do { _Pragma("unroll") for (int _i = 0; _i < 2; ++_i) \
        __builtin_amdgcn_global_load_lds((const unsigned*)((const char*)(gbase) + (voff)[_i]), (LAS unsigned*)(lds + (bufoff) + ldsw + _i * 8192), 16, 0, 0); } while (0)
#define PG8_LDA(dst, b, h) do { _Pragma("unroll") for (int m = 0; m < 4; ++m) _Pragma("unroll") for (int k = 0; k < 2; ++k) dst[m][k] = *(const LAS bf16x8*)(lds + PG8_SA(b, h) + aoff + m * 2048 + k * 1024); } while (0)
#define PG8_LDB(dst, b, h) do { _Pragma("unroll") for (int n = 0; n < 2; ++n) _Pragma("unroll") for (int k = 0; k < 2; ++k) dst[n][k] = *(const LAS bf16x8*)(lds + PG8_SB(b, h) + boff + n * 2048 + k * 1024); } while (0)
#define PG8_MMA(ai, bj, At, Bt) do { __builtin_amdgcn_s_setprio(1); _Pragma("unroll") for (int m = 0; m < 4; ++m) _Pragma("unroll") for (int n = 0; n < 2; ++n) _Pragma("unroll") for (int k = 0; k < 2; ++k) \
        acc[ai][bj][m][n] = __builtin_amdgcn_mfma_f32_16x16x32_bf16(Bt[n][k], At[m][k], acc[ai][bj][m][n], 0, 0, 0); __builtin_amdgcn_s_setprio(0); } while (0)
#define PG8_WAIT_V(n) asm volatile("s_waitcnt vmcnt(" #n ")" ::: "memory")
#define PG8_WAIT_L(n) asm volatile("s_waitcnt lgkmcnt(" #n ")" ::: "memory")
#define PG8_BAR __builtin_amdgcn_s_barrier()
#define PG8_SCHED __builtin_amdgcn_sched_barrier(0)

template <class Epi, class Sched, bool GATHER>
DI void gemm_phase(LAS unsigned char* lds, const int K_, const Sched& S, const Epi& E) {
    int K = K_; asm volatile("" : "+s"(K));
    const int tid = opaque_tid(), wid = __builtin_amdgcn_readfirstlane(tid >> 6), lane = tid & 63, wr = wid >> 2, wc = wid & 3, fr = lane & 15, fq = lane >> 4;
    constexpr bool THIN = Epi::THIN;
#define PG8_WAIT_VK() do { if (THIN) PG8_WAIT_V(6); else PG8_WAIT_V(8); } while (0)
    const int nt = K / BK;
    unsigned voffB[2];
#pragma unroll
    for (int i = 0; i < 2; ++i) { int R, C; stage_rc(tid * 16 + i * 8192, R, C); const int Rb = Epi::PERM ? ((R & ~31) + perm32(R & 31)) : R;
        voffB[i] = (unsigned)(Rb * K + C) * 2u; }
    const size_t kstep = (size_t)(BK * 2);
    const size_t hstepB = (size_t)HALF * K * 2;
    const unsigned ldsw = (unsigned)wid * 1024u;
    const int aoff = lds_byte(wr * 64 + fr, fq * 8), boff = lds_byte(wc * 32 + fr, fq * 8);
    Unit cur, nxt; int ui = 0;
    if (!S.next(0, cur)) return;
    unsigned voffA[GATHER ? 2 : 1][2]; unsigned hstepA = 0;
#define PG8_SETA(UU) do { _Pragma("unroll") for (int _i = 0; _i < 2; ++_i) { int R, C; stage_rc(tid * 16 + _i * 8192, R, C); \
        voffA[0][_i] = S.a_rowoff(UU, R) + (unsigned)(C * 2); if (GATHER) voffA[GATHER ? 1 : 0][_i] = S.a_rowoff(UU, HALF + R) + (unsigned)(C * 2); } } while (0)
    const char* cA = S.a_ptr(cur); const char* cB = S.b_ptr(cur);
    PG8_STAGE(PG8_SB(0, 0), cB, voffB); PG8_STAGE(PG8_SB(0, 1), cB + hstepB, voffB);
    PG8_SETA(cur);
    if (!GATHER) hstepA = S.a_rowoff(cur, HALF);
#define VA0 voffA[0]
#define VA1 voffA[GATHER ? 1 : 0]
    f32x4 acc[2][2][4][2];
#pragma unroll
    for (int a = 0; a < 2; ++a)
#pragma unroll
        for (int b = 0; b < 2; ++b)
#pragma unroll
            for (int m = 0; m < 4; ++m)
#pragma unroll
                for (int n = 0; n < 2; ++n) acc[a][b][m][n] = (f32x4){0.f, 0.f, 0.f, 0.f};
    bf16x8 At[4][2], B0[2][2], B1[2][2];
    S.a_ready(cur, tid, 0u);
    PG8_STAGE(PG8_SA(0, 0), cA, VA0); if (!THIN) PG8_STAGE(PG8_SA(0, 1), cA + hstepA, VA1);
    if (wr == 1) PG8_BAR;
    if (THIN) PG8_WAIT_V(0); else PG8_WAIT_V(2);
    PG8_BAR;
    PG8_STAGE(PG8_SB(1, 0), cB + kstep, voffB); PG8_STAGE(PG8_SA(1, 0), cA + kstep, VA0); PG8_STAGE(PG8_SB(1, 1), cB + hstepB + kstep, voffB);
    PG8_WAIT_V(6); PG8_BAR;
    for (;;) {
        const bool has_next = S.next(ui + 1, nxt);
        const unsigned erd = has_next ? S.early(nxt, tid) : 0u;
        const char* nA = has_next ? S.a_ptr(nxt) : cA; const char* nB = has_next ? S.b_ptr(nxt) : cB;
        for (int t = 0; t < nt; t += 2) {
            const bool last = (t == nt - 2);
            const char* a1 = cA + (size_t)(t + 1) * kstep;
            const char* a2 = last ? nA : cA + (size_t)(t + 2) * kstep; const char* b2 = last ? nB : cB + (size_t)(t + 2) * kstep;
            const char* a3 = a2 + kstep; const char* b3 = b2 + kstep;
            const bool sw = GATHER && last && has_next;
            if (last && has_next) S.a_ready(nxt, tid, erd);
            PG8_LDB(B0, 0, 0); PG8_LDB(B1, 0, 1); PG8_SCHED; PG8_LDA(At, 0, 0); if (!THIN) PG8_STAGE(PG8_SA(1, 1), a1 + hstepA, VA1);
            PG8_WAIT_VK(); PG8_WAIT_L(0); PG8_BAR; PG8_MMA(0, 0, At, B0); PG8_MMA(0, 1, At, B1); PG8_BAR; PG8_SCHED;
            if (sw) PG8_SETA(nxt);
            if (!THIN) PG8_LDA(At, 0, 1); PG8_STAGE(PG8_SB(0, 0), b2, voffB); PG8_STAGE(PG8_SB(0, 1), b2 + hstepB, voffB); PG8_STAGE(PG8_SA(0, 0), a2, VA0);
            PG8_WAIT_VK(); PG8_WAIT_L(0); PG8_BAR; if (!THIN) { PG8_MMA(1, 0, At, B0); PG8_MMA(1, 1, At, B1); } PG8_BAR; PG8_SCHED;
            PG8_LDB(B0, 1, 0); PG8_LDB(B1, 1, 1); PG8_SCHED; PG8_LDA(At, 1, 0); if (!THIN) PG8_STAGE(PG8_SA(0, 1), a2 + hstepA, VA1);
            PG8_WAIT_VK(); PG8_WAIT_L(0); PG8_BAR; PG8_MMA(0, 0, At, B0); PG8_MMA(0, 1, At, B1); PG8_BAR; PG8_SCHED;
            if (!THIN) PG8_LDA(At, 1, 1); PG8_STAGE(PG8_SB(1, 0), b3, voffB); PG8_STAGE(PG8_SB(1, 1), b3 + hstepB, voffB); PG8_STAGE(PG8_SA(1, 0), a3, VA0);
            PG8_WAIT_VK(); PG8_WAIT_L(0); PG8_BAR; if (!THIN) { PG8_MMA(1, 0, At, B0); PG8_MMA(1, 1, At, B1); } PG8_BAR; PG8_SCHED;
        }
        if (wr == 0) PG8_BAR;
        E(acc, cur, wr, wc, fr, fq);
        S.done(cur, tid);
        if (!has_next) break;
#pragma unroll
        for (int a = 0; a < 2; ++a)
#pragma unroll
            for (int b = 0; b < 2; ++b)
#pragma unroll
                for (int m = 0; m < 4; ++m)
#pragma unroll
                    for (int n = 0; n < 2; ++n) acc[a][b][m][n] = (f32x4){0.f, 0.f, 0.f, 0.f};
        cur = nxt; cA = nA; cB = nB; ++ui;
        if (wr == 1) PG8_BAR;
    }
    PG8_WAIT_V(0);
    PG8_BAR;
#undef PG8_SETA
#undef VA0
#undef VA1
}
}
using pg8::Unit;

struct Params {
    const float *x, *c, *w_mod, *b_mod, *norm_mix, *norm_ffn, *w_in, *kv_norm, *w_kv_up, *sgu_norm, *w_s, *b_s, *w_o, *w_pool, *pool_scale,
                *w_gr, *b_gr, *w_er, *b_er, *w_gate, *w_up, *w_down, *norm_out;
    float* out; unsigned char* ws;
};

struct EpiProj {
    static constexpr bool PERM = true, THIN = false;
    bf16_t* O;
    DI void operator()(const f32x4 (&acc)[2][2][4][2], const Unit& u, int wr, int wc, int fr, int fq) const {
        const int row0 = u.pm * 256 + wr * 64 + fr, col0 = u.pn * 256 + wc * 32 + 8 * fq;
        const bool act = (u.pn >= 4 && u.pn < 8);
        const __amdgpu_buffer_rsrc_t rs = __builtin_amdgcn_make_buffer_rsrc(O, 0, 0x7fffffff, 0x00020000);
#pragma unroll
        for (int ai = 0; ai < 2; ++ai)
#pragma unroll
            for (int m = 0; m < 4; ++m) { bf16_t* rowp = O + (size_t)(row0 + ai * 128 + m * 16) * DINP + col0;
#pragma unroll
                for (int bj = 0; bj < 2; ++bj) { f32x4 v0 = acc[ai][bj][m][0], v1 = acc[ai][bj][m][1];
                    if (act) {
#pragma unroll
                        for (int j = 0; j < 4; ++j) { v0[j] = gelu_tanh(v0[j]); v1[j] = gelu_tanh(v1[j]); } }
                    u32x4 w; w.x = pk2(v0[0], v0[1]); w.y = pk2(v0[2], v0[3]); w.z = pk2(v1[0], v1[1]); w.w = pk2(v1[2], v1[3]);
                    if (act) __builtin_amdgcn_raw_buffer_store_b128(w, rs, (int)(((unsigned)(row0 + ai * 128 + m * 16) * (unsigned)DINP + (unsigned)(col0 + bj * 128)) * 2u), 0, 16);
                    else *(u32x4*)(rowp + bj * 128) = w; } }
    }
};
struct EpiY {
    static constexpr bool PERM = true, THIN = false;
    bf16_t* Y; const float* gm; const float* scale;
    DI void operator()(const f32x4 (&acc)[2][2][4][2], const Unit& u, int wr, int wc, int fr, int fq) const {
        const int row0 = u.pm * 256 + wr * 64 + fr, col0 = u.pn * 256 + wc * 32 + 8 * fq, b = u.pm >> 3;
        f32x4 gv[2][2];
#pragma unroll
        for (int bj = 0; bj < 2; ++bj)
#pragma unroll
            for (int n = 0; n < 2; ++n) { gv[bj][n] = *(const f32x4*)(gm + (size_t)b * 6144 + col0 + bj * 128 + n * 4);
                if (scale) gv[bj][n] *= *(const f32x4*)(scale + col0 + bj * 128 + n * 4); }
#pragma unroll
        for (int ai = 0; ai < 2; ++ai)
#pragma unroll
            for (int m = 0; m < 4; ++m) { bf16_t* rowp = Y + (size_t)(row0 + ai * 128 + m * 16) * DM + col0;
#pragma unroll
                for (int bj = 0; bj < 2; ++bj) { const f32x4 v0 = acc[ai][bj][m][0] * gv[bj][0], v1 = acc[ai][bj][m][1] * gv[bj][1];
                    u32x4 w; w.x = pk2(v0[0], v0[1]); w.y = pk2(v0[2], v0[3]); w.z = pk2(v1[0], v1[1]); w.w = pk2(v1[2], v1[3]);
                    *(u32x4*)(rowp + bj * 128) = w; } }
    }
};
struct EpiX {
    static constexpr bool PERM = true, THIN = false;
    xh_t* X; const float* gm; const float* scale;
    DI void operator()(const f32x4 (&acc)[2][2][4][2], const Unit& u, int wr, int wc, int fr, int fq) const {
        const int row0 = u.pm * 256 + wr * 64 + fr, col0 = u.pn * 256 + wc * 32 + 8 * fq, b = u.pm >> 3;
        const __amdgpu_buffer_rsrc_t xrs = __builtin_amdgcn_make_buffer_rsrc(X, 0, 0x7fffffff, 0x00020000);
        u32x4 xr[2][4][2];
#pragma unroll
        for (int ai = 0; ai < 2; ++ai)
#pragma unroll
            for (int m = 0; m < 4; ++m)
#pragma unroll
                for (int bj = 0; bj < 2; ++bj) xr[ai][m][bj] = *(const u32x4*)(X + (size_t)(row0 + ai * 128 + m * 16) * DM + col0 + bj * 128);
        f32x4 gv[2][2];
#pragma unroll
        for (int bj = 0; bj < 2; ++bj)
#pragma unroll
            for (int n = 0; n < 2; ++n) { gv[bj][n] = *(const f32x4*)(gm + (size_t)b * 6144 + col0 + bj * 128 + n * 4);
                if (scale) gv[bj][n] *= *(const f32x4*)(scale + col0 + bj * 128 + n * 4); }
#pragma unroll
        for (int ai = 0; ai < 2; ++ai)
#pragma unroll
            for (int m = 0; m < 4; ++m) { const unsigned rowb = ((unsigned)(row0 + ai * 128 + m * 16) * (unsigned)DM + (unsigned)col0) * 2u;
#pragma unroll
                for (int bj = 0; bj < 2; ++bj) { const f32x4 v0 = acc[ai][bj][m][0] * gv[bj][0], v1 = acc[ai][bj][m][1] * gv[bj][1];
                    const u32x4 xw = xr[ai][m][bj];
                    const h16x4 x0 = __builtin_bit_cast(h16x4, (u32x2){xw.x, xw.y}), x1 = __builtin_bit_cast(h16x4, (u32x2){xw.z, xw.w});
                    const h16x4 o0 = __builtin_convertvector(__builtin_convertvector(x0, f32x4) + v0, h16x4), o1 = __builtin_convertvector(__builtin_convertvector(x1, f32x4) + v1, h16x4);
                    const u32x2 p0 = __builtin_bit_cast(u32x2, o0), p1 = __builtin_bit_cast(u32x2, o1);
                    __builtin_amdgcn_raw_buffer_store_b128((u32x4){p0.x, p0.y, p1.x, p1.y}, xrs, (int)(rowb + bj * 256u), 0, 16); } }
    }
};
template <bool THIN_>
struct EpiGU {
    static constexpr bool PERM = true, THIN = THIN_;
    bf16_t* act; const float* gates;
    DI void operator()(const f32x4 (&acc)[2][2][4][2], const Unit& u, int wr, int wc, int fr, int fq) const {
        const int e = u.aux & 0xff, ml = (u.aux >> 8) & 0xff, hs = (u.aux >> 16) & 1;
        const int f0 = u.pn * 128 + wc * 32 + 8 * fq;
        const __amdgpu_buffer_rsrc_t rs = __builtin_amdgcn_make_buffer_rsrc(act, 0, 0x7fffffff, 0x00020000);
#pragma unroll
        for (int ai = 0; ai < (THIN_ ? 1 : 2); ++ai)
#pragma unroll
            for (int m = 0; m < 4; ++m) { const int r = (THIN_ ? hs : ai) * 128 + wr * 64 + m * 16 + fr;
                const float gt = gates[(size_t)e * CAP + ml * 256 + r];
                const f32x4 g0 = acc[ai][0][m][0], g1 = acc[ai][0][m][1], u0 = acc[ai][1][m][0], u1 = acc[ai][1][m][1];
                float o[8];
#pragma unroll
                for (int j = 0; j < 4; ++j) { o[j] = silu_f(g0[j]) * u0[j] * gt; o[4 + j] = silu_f(g1[j]) * u1[j] * gt; }
                u32x4 w; w.x = pk2(o[0], o[1]); w.y = pk2(o[2], o[3]); w.z = pk2(o[4], o[5]); w.w = pk2(o[6], o[7]);
                __builtin_amdgcn_raw_buffer_store_b128(w, rs, (int)(((unsigned)(u.pm * 256 + r) * 256u + (unsigned)f0) * 2u), 0, 16); }
    }
};
struct EpiDown {
    static constexpr bool PERM = true, THIN = false;
    bf16_t* Y; const LAS int* toff; const LAS int* cnt;
    DI void operator()(const f32x4 (&acc)[2][2][4][2], const Unit& u, int wr, int wc, int fr, int fq) const {
        const int row0 = u.pm * 256 + wr * 64 + fr, col0 = u.pn * 256 + wc * 32 + 8 * fq;
        const int nvalid = cnt[u.aux] - (u.pm - toff[u.aux]) * 256;
#pragma unroll
        for (int ai = 0; ai < 2; ++ai)
#pragma unroll
            for (int m = 0; m < 4; ++m) { bf16_t* rowp = Y + (size_t)(row0 + ai * 128 + m * 16) * DM + col0;
                if (wr * 64 + fr + ai * 128 + m * 16 >= nvalid) continue;
#pragma unroll
                for (int bj = 0; bj < 2; ++bj) { const f32x4 v0 = acc[ai][bj][m][0], v1 = acc[ai][bj][m][1];
                    u32x4 w; w.x = pk2(v0[0], v0[1]); w.y = pk2(v0[2], v0[3]); w.z = pk2(v1[0], v1[1]); w.w = pk2(v1[2], v1[3]);
                    *(u32x4*)(rowp + bj * 128) = w; } }
    }
};

DI int moe_find(const LAS int* toff, int mt) { return toff[256 + mt]; }
struct MoeGUSched {
    const LAS int* toff; const LAS int* cnt; int T, G, c, halves; const int* tokidx; const char* H; const char* W; unsigned* mtc;
    DI bool next(int i, Unit& u) const { if (i > 0) return false; int L, hs = 0;
        if (!halves) { const int nw = (2 * T < G) ? 2 * T : G; if (c >= nw) return false;
            const int q = nw / pg8::NXCD, r = nw % pg8::NXCD, xcd = c % pg8::NXCD, off = c / pg8::NXCD; L = (xcd < r ? xcd * (q + 1) : r * (q + 1) + (xcd - r) * q) + off; }
        else { const int extra = 2 * T - G; if (extra <= 0 || c >= 2 * extra) return false;
            const int nh = 2 * extra, q = nh / pg8::NXCD, r = nh % pg8::NXCD, xcd = c % pg8::NXCD, off = c / pg8::NXCD, h = (xcd < r ? xcd * (q + 1) : r * (q + 1) + (xcd - r) * q) + off;
            L = G + (h >> 1); hs = h & 1; }
        const int mt = L >> 1; const int e = moe_find(toff, mt);
        u.pm = mt; u.pn = L & 1; u.aux = e | ((mt - toff[e]) << 8) | (hs << 16) | (halves << 17); return true; }
    DI const char* a_ptr(const Unit&) const { return H; }
    DI const char* b_ptr(const Unit& u) const { return W + ((size_t)((u.aux & 0xff) * 512 + u.pn * 256)) * 2048; }
    DI unsigned a_rowoff(const Unit& u, int r) const { const int e = u.aux & 0xff; int slot = ((u.aux >> 8) & 0xff) * 256 + ((u.aux >> 16) & 1) * 128 + r; const int ce = cnt[e]; slot = slot < ce ? slot : ce - 1;
        return (unsigned)tokidx[(size_t)e * CAP + slot] * 2048u; }
    DI void a_ready(const Unit&, int, unsigned) const {}
    DI unsigned early(const Unit&, int) const { return 0u; }
    DI void done(const Unit& u, int tid) const {
        asm volatile("s_waitcnt vmcnt(0)" ::: "memory");
        if ((tid & 63) == 0) (void)__hip_atomic_fetch_add(mtc + 64 * u.pm, ((u.aux >> 17) & 1) ? 1u : 2u, __ATOMIC_RELAXED, __HIP_MEMORY_SCOPE_AGENT);
    }
};
struct MoeDownSched {
    const LAS int* toff; int T, G, c; const char* ACT; const char* W; unsigned* mtc; unsigned* tmo;
    DI bool next(int i, Unit& u) const {
        const int R = (2 * T > G) ? ((2 * (2 * T - G)) < G ? (2 * (2 * T - G)) : G) : 0;
        const int E4 = 4 * ((T < G / 2) ? T : G / 2), n = G - R;
        int j;
        if (n > 0) {
            int ne = 0, pos = 0, lo = c;
            if (c < R) { const int q = R / pg8::NXCD, r = R % pg8::NXCD, x = c % pg8::NXCD, off = c / pg8::NXCD; lo = (x < r ? x * (q + 1) : r * (q + 1) + (x - r) * q) + off; }
            if (c >= R) { const int x = c % pg8::NXCD;
#pragma unroll
                for (int y = 0; y < pg8::NXCD; ++y) if (y < x) pos += (G + 7 - y) / 8 - (R + 7 - y) / 8;
                pos += c / 8 - (R + 7 - x) / 8;
                ne = (pos < E4) ? (E4 - pos + n - 1) / n : 0; lo = R + (n - 1 - pos); }
            j = (i < ne) ? pos + i * n : E4 + lo + (i - ne) * G; }
        else j = c + i * G;
        if (j >= 4 * T) return false;
        const int mt = j >> 2; const int e = moe_find(toff, mt);
        u.pm = mt; u.pn = j & 3; u.aux = e; return true; }
    DI const char* a_ptr(const Unit& u) const { return ACT + (size_t)u.pm * (256 * 512); }
    DI const char* b_ptr(const Unit& u) const { return W + ((size_t)(u.aux * 1024 + u.pn * 256)) * 512; }
    DI unsigned a_rowoff(const Unit&, int r) const { return (unsigned)r * 512u; }
    DI unsigned early(const Unit& u, int tid) const { return (tid < 64) ? __hip_atomic_load(mtc + 64 * u.pm, __ATOMIC_RELAXED, __HIP_MEMORY_SCOPE_AGENT) : 0u; }
    DI void a_ready(const Unit& u, int tid, unsigned erd) const {
        if (tid < 64) {
            unsigned spins = 0;
            while ((unsigned)__builtin_amdgcn_readfirstlane((int)erd) < 32u && (unsigned)__builtin_amdgcn_readfirstlane((int)__hip_atomic_load(mtc + 64 * u.pm, __ATOMIC_RELAXED, __HIP_MEMORY_SCOPE_AGENT)) < 32u) {
                __builtin_amdgcn_s_sleep(2);
                if (++spins > (1u << 20)) { if (tid == 0) __hip_atomic_store(tmo, 1u, __ATOMIC_RELAXED, __HIP_MEMORY_SCOPE_AGENT); break; } }
            __builtin_amdgcn_fence(__ATOMIC_ACQUIRE, "agent");
            asm volatile("s_waitcnt vmcnt(0)" ::: "memory");
        }
        asm volatile("" ::: "memory"); __builtin_amdgcn_s_barrier(); asm volatile("" ::: "memory");
    }
    DI void done(const Unit&, int) const {}
};
DI int moe_tables(unsigned* ctl, int L, LAS int* toff, LAS int* cntl, int tid) {
    if (tid < 64) {
        const int c = (tid < NEXP) ? (int)xb_ld(ctl + CW_CNT + 64 * L + (tid & 31)) : 0;
        const int tl = (c + 255) >> 8;
        int incl = tl;
#pragma unroll
        for (int o = 1; o < 32; o <<= 1) { const int v = __builtin_amdgcn_ds_bpermute((tid - o) << 2, incl); if (tid >= o) incl += v; }
        if (tid < NEXP) { cntl[tid] = c; toff[tid] = incl - tl;
#pragma unroll 1
            for (int ml = 0; ml < tl; ++ml) toff[256 + incl - tl + ml] = tid; }
        if (tid == NEXP - 1) toff[NEXP] = incl;
    }
    __syncthreads();
    return toff[NEXP];
}

DI void cvt_item(const float* src, int ldn, int nvalid, bf16_t* dst, int ldk, LAS float* scr, int lane) {
#pragma unroll 8
    for (int i = 0; i < 32; ++i) { const int kk = 2 * i + (lane >> 5); scr[kk * 33 + (lane & 31)] = __builtin_nontemporal_load(src + (size_t)kk * ldn + (lane & 31)); }
    LDS_WAIT(); asm volatile("" ::: "memory");
    const int c = lane & 7;
#pragma unroll
    for (int j = 0; j < 4; ++j) { const int n = (lane >> 3) + 8 * j; const LAS float* s = scr + (8 * c) * 33 + n;
        u32x4 o; o.x = pk2(s[0 * 33], s[1 * 33]); o.y = pk2(s[2 * 33], s[3 * 33]); o.z = pk2(s[4 * 33], s[5 * 33]); o.w = pk2(s[6 * 33], s[7 * 33]);
        if (n < nvalid) *(u32x4*)(dst + (size_t)n * ldk + 8 * c) = o; }
    LDS_WAIT(); asm volatile("" ::: "memory");
}
DI void cvt_moe_item(const Params& p, unsigned char* ws, int le, int r, LAS float* scr, int lane) {
    bf16_t* wgu = (bf16_t*)(ws + WS_WGU); bf16_t* wdn = (bf16_t*)(ws + WS_WDN);
    if (r < 256) { const bool up = r >= 128; r &= 127; const int kb = r >> 3, nb = r & 7;
        const float* src = (up ? p.w_up : p.w_gate) + ((size_t)le * 1024 + kb * 64) * 256 + nb * 32;
        const int drow = (nb >> 2) * 256 + (up ? 128 : 0) + (nb & 3) * 32;
        cvt_item(src, 256, 32, wgu + ((size_t)le * 512 + drow) * 1024 + kb * 64, 1024, scr, lane);
    } else { r -= 256; const int kb = r >> 5, nb = r & 31;
        const float* src = p.w_down + ((size_t)le * 256 + kb * 64) * 1024 + nb * 32;
        cvt_item(src, 1024, 32, wdn + ((size_t)le * 1024 + nb * 32) * 256 + kb * 64, 256, scr, lane); }
}
DI void p0_prologue(const Params& p, LAS unsigned char* lds, int G, int bid) {
    const int tid = opaque_tid(), lane = tid & 63, wave = __builtin_amdgcn_readfirstlane(tid >> 6);
    unsigned char* ws = opaque_ws(p.ws);
    LAS float* scr = (LAS float*)(lds + wave * 16384);
    const int gw = bid * 8 + wave, NGW = G * 8;
    constexpr int I_MOE = 4 * 32 * 384, I_WIN = 2 * 16 * 71, I_WO = 2 * 16 * 32, I_KV = 2 * 2 * 4, I_POOL = 2 * 4 * 4 * 8;
    constexpr int NITEMS = I_MOE + I_WIN + I_WO + I_KV + I_POOL;
    bf16_t* win = (bf16_t*)(ws + WS_WIN); bf16_t* wo = (bf16_t*)(ws + WS_WO);
    bf16_t* wkv = (bf16_t*)(ws + WS_WKV); bf16_t* wpl = (bf16_t*)(ws + WS_WPOOL);
    for (int it = gw; it < NITEMS; it += NGW) {
        int r = it;
        if (r < I_MOE) { cvt_moe_item(p, ws, 127 - r / 384, r % 384, scr, lane); continue; }
        r -= I_MOE;
        if (r < I_WIN) {
            const int j = r / (16 * 71); r -= j * (16 * 71); const int kb = r / 71, cb = r % 71;
            int sc, dr, nv = 32;
            if (cb < 16) { sc = cb * 32; dr = PC_Q + cb * 32; }
            else if (cb < 20) { sc = 512 + (cb - 16) * 32; dr = PC_KVL + (cb - 16) * 32; }
            else if (cb < 36) { sc = 640 + (cb - 20) * 32; dr = PC_QI + (cb - 20) * 32; }
            else if (cb < 38) { sc = 1152 + (cb - 36) * 32; dr = PC_KI + (cb - 36) * 32; }
            else if (cb < 39) { sc = 1216; dr = PC_WI; nv = 8; }
            else if (cb < 55) { sc = 1224 + (cb - 39) * 32; dr = PC_U + (cb - 39) * 32; }
            else { sc = 1736 + (cb - 55) * 32; dr = PC_V + (cb - 55) * 32; }
            cvt_item(p.w_in + ((size_t)j * 1024 + kb * 64) * DIN + sc, DIN, nv, win + ((size_t)j * DINP + dr) * 1024 + kb * 64, 1024, scr, lane);
            continue; }
        r -= I_WIN;
        if (r < I_WO) { const int j = r / 512; r -= j * 512; const int kb = r >> 5, nb = r & 31;
            cvt_item(p.w_o + ((size_t)j * 1024 + kb * 64) * 1024 + nb * 32, 1024, 32, wo + ((size_t)j * 1024 + nb * 32) * 1024 + kb * 64, 1024, scr, lane);
            continue; }
        r -= I_WO;
        if (r < I_KV) { const int j = r >> 3; r &= 7; const int kb = r >> 2, nb = r & 3;
            cvt_item(p.w_kv_up + ((size_t)j * 128 + kb * 64) * 128 + nb * 32, 128, 32, wkv + ((size_t)j * 128 + nb * 32) * 128 + kb * 64, 128, scr, lane);
            continue; }
        r -= I_KV;
        { const int jg = r >> 5; r &= 31; const int kb = r >> 3, nb = r & 7;
            cvt_item(p.w_pool + ((size_t)jg * 256 + kb * 64) * 256 + nb * 32, 256, 32, wpl + ((size_t)jg * 256 + nb * 32) * 256 + kb * 64, 256, scr, lane); }
    }
    {
        const int gt = bid * 512 + tid, NGT = G * 512;
        bf16_t* wsb = (bf16_t*)(ws + WS_WS);
        for (int i = gt; i < 2 * 4 * 128 * 128; i += NGT) { const int jj = i & 127, ii = (i >> 7) & 127; const float v = ((jj >> 6) <= (ii >> 6)) ? p.w_s[i] : 0.f; wsb[i] = (bf16_t)(pk2(v, 0.f) & 0xffffu); }
        bf16_t* wrh = (bf16_t*)(ws + WS_WR); bf16_t* wrl = wrh + 4 * 48 * 1024;
        for (int i = gt; i < 4 * 48 * 1024; i += NGT) { const int k = i & 1023, n = (i >> 10) % 48, l = i / (48 * 1024);
            float w = 0.f; if (n < 4) w = p.w_gr[((size_t)l * 1024 + k) * 4 + n]; else if (n < 36) w = p.w_er[((size_t)l * 1024 + k) * 32 + (n - 4)];
            const unsigned hi = pk2(w, 0.f) & 0xffffu; const float rem = w - bflo(hi);
            wrh[i] = (bf16_t)hi; wrl[i] = (bf16_t)(pk2(rem, 0.f) & 0xffffu); }
    }
    __syncthreads();
    {
        LAS float* cs = (LAS float*)lds;
        LAS float* red = (LAS float*)(lds + 32768);
        float* mod = (float*)(ws + WS_MOD);
        if (bid < 256) { for (int i = tid; i < 8 * 1024; i += 512) { const float v = p.c[i]; cs[i] = v / (1.0f + __expf(-v)); } }
        __syncthreads();
        for (int u = bid; u < 256; u += G) {
            const int l = u >> 6, n0 = (u & 63) * 96, q = tid & 31, kg = tid >> 5;
            f32x4 acc[8];
#pragma unroll
            for (int b = 0; b < 8; ++b) acc[b] = (f32x4){0.f, 0.f, 0.f, 0.f};
            const float* wp = p.w_mod + ((size_t)l * 1024 + kg * 64) * 6144 + n0 + 4 * q;
            if (q < 24)
#pragma unroll 8
            for (int kk = 0; kk < 64; ++kk) { const f32x4 w = __builtin_nontemporal_load((const f32x4*)(wp + (size_t)kk * 6144));
#pragma unroll
                for (int b = 0; b < 8; ++b) acc[b] += cs[b * 1024 + kg * 64 + kk] * w; }
#pragma unroll
            for (int b = 0; b < 8; ++b) *(LAS f32x4*)(red + (kg * 8 + b) * 128 + 4 * q) = acc[b];
            __syncthreads();
#pragma unroll
            for (int o2 = 0; o2 < 2; ++o2) { const int o = tid * 2 + o2, b = o >> 7, cc = o & 127;
                if (cc < 96) { float s = p.b_mod[(size_t)l * 6144 + n0 + cc];
#pragma unroll
                    for (int k2 = 0; k2 < 16; ++k2) s += red[(k2 * 8 + b) * 128 + cc];
                    mod[((size_t)l * 8 + b) * 6144 + n0 + cc] = s; } }
            __syncthreads();
        }
    }
}

template <int MODE>
DI void norm_rows(const Params& p, int L, const float* xin32  , const xh_t* xin, xh_t* xout, const bool add, const LAS int* toff, int G, int bid, unsigned* nrc = nullptr) {
    const int tid = opaque_tid(), lane = tid & 63, wave = __builtin_amdgcn_readfirstlane(tid >> 6);
    unsigned char* ws = opaque_ws(p.ws);
    const float* mod = (const float*)(ws + WS_MOD);
    const unsigned* tokmeta = (const unsigned*)(ws + WS_TOKMETA);
    const bf16_t* ymoe = (const bf16_t*)(ws + WS_YMOE);
    bf16_t* hb = (bf16_t*)(ws + WS_H);
    float* rstdb = (float*)(ws + WS_RSTD);
    const int NGW = G * 8, RPW = (MTOK + NGW - 1) / NGW, rbeg = (bid * 8 + wave) * RPW, rend = (rbeg + RPW) < MTOK ? (rbeg + RPW) : MTOK;
    if (rbeg >= rend) return;
    struct RowOps { f32x4 xf[4]; h16x8 xh[2]; u32x4 y1[2], y2[2]; };
    RowOps opA, opB;
    unsigned tm = 0u;
    if (add && lane < 2 * (rend - rbeg)) tm = tokmeta[rbeg * 2 + lane];
    asm volatile("" : "+v"(tm));
#define NR_COL(k) (8 * lane + 512 * ((k) >> 1) + 4 * ((k) & 1))
    auto issue = [&](RowOps& o, int ROW) {
        if (xin32) { const float* xr_ = xin32 + (size_t)ROW * DM;
#pragma unroll
            for (int k = 0; k < 4; ++k) o.xf[k] = __builtin_nontemporal_load((const f32x4*)(xr_ + NR_COL(k))); }
        else { const xh_t* xr_ = xin + (size_t)ROW * DM + 8 * lane;
#pragma unroll
            for (int j = 0; j < 2; ++j) o.xh[j] = *(const h16x8*)(xr_ + 512 * j); }
        if (add) { const int kk = ROW - rbeg;
            const unsigned M1 = (unsigned)__builtin_amdgcn_readlane((int)tm, 2 * kk), M2 = (unsigned)__builtin_amdgcn_readlane((int)tm, 2 * kk + 1);
            const int p1_ = toff[M1 >> 16] * 256 + (int)(M1 & 0xffffu), p2_ = toff[M2 >> 16] * 256 + (int)(M2 & 0xffffu);
            const bf16_t* a_ = ymoe + (size_t)p1_ * DM + 8 * lane; const bf16_t* c_ = ymoe + (size_t)p2_ * DM + 8 * lane;
#pragma unroll
            for (int j = 0; j < 2; ++j) { o.y1[j] = *(const u32x4*)(a_ + 512 * j); o.y2[j] = *(const u32x4*)(c_ + 512 * j); } } };
    int bcur = -1;
    f32x4 gfv[4], Gv[4], Sv[4];
    auto proc = [&](RowOps& o, const int row, const int nrow) {
        const int b = row >> 11;
        if (b != bcur) { bcur = b;
            if (add) { const float* gf = mod + ((size_t)(L - 1) * 8 + b) * 6144 + 5120;
#pragma unroll
                for (int k = 0; k < 4; ++k) gfv[k] = *(const f32x4*)(gf + NR_COL(k)); }
            if (MODE == 0) { const float* nw = p.norm_mix + (size_t)L * DM;
                const float* sh = mod + ((size_t)L * 8 + b) * 6144; const float* sc = mod + ((size_t)L * 8 + b) * 6144 + 1024;
#pragma unroll
                for (int k = 0; k < 4; ++k) { Gv[k] = *(const f32x4*)(nw + NR_COL(k)) * (*(const f32x4*)(sc + NR_COL(k)) + 1.0f); Sv[k] = *(const f32x4*)(sh + NR_COL(k)); } }
            if (MODE == 3) { const float* nw = p.norm_out;
#pragma unroll
                for (int k = 0; k < 4; ++k) Gv[k] = *(const f32x4*)(nw + NR_COL(k)); } }
        f32x4 v[4];
#pragma unroll
        for (int k = 0; k < 4; ++k) {
            if (xin32) v[k] = o.xf[k];
            else { const h16x8 w = o.xh[k >> 1]; const h16x4 hh = (k & 1) ? __builtin_shufflevector(w, w, 4, 5, 6, 7) : __builtin_shufflevector(w, w, 0, 1, 2, 3); v[k] = __builtin_convertvector(hh, f32x4); }
            if (add) { const u32x4 a4 = o.y1[k >> 1], c4 = o.y2[k >> 1]; const unsigned a0 = (k & 1) ? a4.z : a4.x, a1 = (k & 1) ? a4.w : a4.y, c0 = (k & 1) ? c4.z : c4.x, c1 = (k & 1) ? c4.w : c4.y;
                const f32x4 g = gfv[k];
                v[k].x += g.x * (bflo(a0) + bflo(c0)); v[k].y += g.y * (bfhi(a0) + bfhi(c0)); v[k].z += g.z * (bflo(a1) + bflo(c1)); v[k].w += g.w * (bfhi(a1) + bfhi(c1)); } }
        if (nrow >= 0) issue(o, nrow);
        if (MODE != 3) {
            const __amdgpu_buffer_rsrc_t xrs = __builtin_amdgcn_make_buffer_rsrc(xout, 0, 0x7fffffff, 0x00020000);
#pragma unroll
            for (int j = 0; j < 2; ++j) { const h16x4 h0 = __builtin_convertvector(v[2 * j], h16x4), h1 = __builtin_convertvector(v[2 * j + 1], h16x4);
                const u32x2 w0 = __builtin_bit_cast(u32x2, h0), w1 = __builtin_bit_cast(u32x2, h1); const u32x4 w = {w0.x, w0.y, w1.x, w1.y};
                if (MODE == 1) __builtin_amdgcn_raw_buffer_store_b128(w, xrs, (int)(((unsigned)row * (unsigned)DM + (unsigned)(8 * lane + 512 * j)) * 2u), 0, 16);
                else *(u32x4*)(xout + (size_t)row * DM + 8 * lane + 512 * j) = w;
                v[2 * j] = __builtin_convertvector(h0, f32x4); v[2 * j + 1] = __builtin_convertvector(h1, f32x4); } }
        float ss = 0.f;
#pragma unroll
        for (int k = 0; k < 4; ++k) ss += (v[k].x * v[k].x + v[k].y * v[k].y) + (v[k].z * v[k].z + v[k].w * v[k].w);
        const float rstd = rsqrtf(wave_sum(ss, lane) * (1.0f / DM) + EPS);
        if (MODE == 0) {
#pragma unroll
            for (int j = 0; j < 2; ++j) { const f32x4 ha = v[2 * j] * rstd * Gv[2 * j] + Sv[2 * j], hb2 = v[2 * j + 1] * rstd * Gv[2 * j + 1] + Sv[2 * j + 1];
                u32x4 o; o.x = pk2(ha.x, ha.y); o.y = pk2(ha.z, ha.w); o.z = pk2(hb2.x, hb2.y); o.w = pk2(hb2.z, hb2.w);
                *(u32x4*)(hb + (size_t)row * DM + 8 * lane + 512 * j) = o; }
        } else if (MODE == 1) {
            if (lane == 0) __hip_atomic_store(rstdb + row, rstd, __ATOMIC_RELAXED, __HIP_MEMORY_SCOPE_AGENT);
        } else {
            float* oo = p.out + (size_t)row * DM;
#pragma unroll
            for (int k = 0; k < 4; ++k) __builtin_nontemporal_store(v[k] * rstd * Gv[k], (f32x4*)(oo + NR_COL(k)));
        }
    };
    issue(opA, rbeg);
    if (rbeg + 1 < rend) issue(opB, rbeg + 1);
#pragma unroll 1
    for (int row = rbeg; row < rend; row += 2) {
        proc(opA, row, (row + 2 < rend) ? row + 2 : -1);
        if (row + 1 < rend) proc(opB, row + 1, (row + 3 < rend) ? row + 3 : -1);
    }
#undef NR_COL
    if (MODE == 1) {
        asm volatile("s_waitcnt vmcnt(0)" ::: "memory");
        if (lane == 0) (void)__hip_atomic_fetch_add(nrc + 64 * (rbeg >> 6), 1u, __ATOMIC_RELAXED, __HIP_MEMORY_SCOPE_AGENT); }
}

template <int WIN>
DI void pool_rows(const xh_t* x, const float* rstdb, const float* gn  , const float* scm  , bf16_t* yo, int row0, int col) {
    const __amdgpu_buffer_rsrc_t yrs = __builtin_amdgcn_make_buffer_rsrc(yo, 0, 0x7fffffff, 0x00020000);
    const int seq0 = row0 & ~(SEQ - 1);
    const f32x4 G4 = *(const f32x4*)(gn + col) * (*(const f32x4*)(scm + col) + 1.0f);
    f32x4 ring[WIN]; f32x4 S = (f32x4){0.f, 0.f, 0.f, 0.f};
#pragma unroll
    for (int i = 0; i < WIN; ++i) ring[i] = (f32x4){0.f, 0.f, 0.f, 0.f};
#pragma unroll
    for (int i = 0; i < 32 + WIN - 1; ++i) {
        const int row = row0 - (WIN - 1) + i;
        const int rowc = row >= seq0 ? row : seq0;
        f32x4 z = ldx4(x + (size_t)rowc * DM + col) * rstdb[rowc];
        if (row < seq0) z = (f32x4){0.f, 0.f, 0.f, 0.f};
        S = S + z - ring[i % WIN]; ring[i % WIN] = z;
        if (i >= WIN - 1) { const int t = row - seq0; const float inv = 1.0f / (float)((t + 1) < WIN ? (t + 1) : WIN);
            const f32x4 y = (S * inv - z) * G4; u32x2 o; o.x = pk2(y.x, y.y); o.y = pk2(y.z, y.w);
            __builtin_amdgcn_raw_buffer_store_b64(o, yrs, (int)(((unsigned)row * (unsigned)DM + (unsigned)col) * 2u), 0, 16); }
    }
}

DI void norm2_phase(const Params& p, LAS unsigned char* lds, int L, int cidx, xh_t* x, int G, int bid) {
    const int tid = opaque_tid(), lane = tid & 63, wave = __builtin_amdgcn_readfirstlane(tid >> 6);
    unsigned char* ws = opaque_ws(p.ws);
    unsigned* ctl = (unsigned*)(ws + WS_CTL);
    const float* mod = (const float*)(ws + WS_MOD);
    bf16_t* hb = (bf16_t*)(ws + WS_H); const bf16_t* yb = (const bf16_t*)(ws + WS_YBUF);
    const bf16_t* wrh = (const bf16_t*)(ws + WS_WR) + (size_t)L * 48 * 1024; const bf16_t* wrl = wrh + 4 * 48 * 1024;
    unsigned* tokmeta = (unsigned*)(ws + WS_TOKMETA); int* tokidx = (int*)(ws + WS_TOKIDX); float* gates = (float*)(ws + WS_GATES);
    constexpr int HP = 1028;
    LAS float* Hf = (LAS float*)lds;
    LAS float* part = (LAS float*)(lds + 16 * HP * 4);
    LAS float* GS = (LAS float*)(lds + 16 * HP * 4 + 8 * 16 * 48 * 4);
    LAS int* dec = (LAS int*)(lds + 16 * HP * 4 + 8 * 16 * 48 * 4 + 8192);
    LAS float* lgt = (LAS float*)(lds + 16 * HP * 4 + 8 * 16 * 48 * 4 + 8192 + 2048);
    LAS int* hist = (LAS int*)(lds + TAB_OFF + 512); LAS int* base = (LAS int*)(lds + TAB_OFF + 768);
    const int r = lane & 15, g = lane >> 4;
    bf16x8 wh[4][3], wl[4][3];
#pragma unroll
    for (int kk = 0; kk < 4; ++kk)
#pragma unroll
        for (int n = 0; n < 3; ++n) { const size_t wo = (size_t)(n * 16 + r) * 1024 + (wave * 4 + kk) * 32 + g * 8; wh[kk][n] = *(const bf16x8*)(wrh + wo); wl[kk][n] = *(const bf16x8*)(wrl + wo); }
    LAS float* rbias = lgt + 16 * 48;
    if (tid < 48) rbias[tid] = (tid < 4) ? p.b_gr[L * 4 + tid] : (tid < 36) ? p.b_er[L * 32 + tid - 4] : 0.f;
    for (int chunk = bid; chunk < MTOK / 64; chunk += G) {
        const int row0 = chunk * 64, b = row0 >> 11;
        { const float* nw = p.norm_ffn + (size_t)L * DM; const float* sh = mod + ((size_t)L * 8 + b) * 6144 + 3072; const float* sc = sh + 1024;
          for (int i = tid; i < DM; i += 512) { GS[i] = nw[i] * (sc[i] + 1.0f); GS[DM + i] = sh[i]; } }
        if (tid < NEXP) hist[tid] = 0;
        if (tid < 64) { unsigned* xp = ctl + CW_XP + (size_t)(L * 64 + (chunk >> 2)) * 64; unsigned spins = 0;
            while ((unsigned)__builtin_amdgcn_readfirstlane((int)__hip_atomic_load(xp, __ATOMIC_RELAXED, __HIP_MEMORY_SCOPE_AGENT)) < 32u) {
                __builtin_amdgcn_s_sleep(2);
                if (++spins > (1u << 20)) { if (tid == 0) __hip_atomic_store(ctl + CW_TMO, 1u, __ATOMIC_RELAXED, __HIP_MEMORY_SCOPE_AGENT); break; } }
            __builtin_amdgcn_fence(__ATOMIC_ACQUIRE, "agent");
            asm volatile("s_waitcnt vmcnt(0)" ::: "memory"); }
        __syncthreads();
        h16x4 nx[2][4];
#pragma unroll
        for (int rr = 0; rr < 2; ++rr) { const int row = row0 + wave * 2 + rr;
#pragma unroll
            for (int j = 0; j < 4; ++j) nx[rr][j] = *(const h16x4*)(x + (size_t)row * DM + 4 * lane + 256 * j); }
        __syncthreads();
#pragma unroll 1
        for (int pass = 0; pass < 4; ++pass) {
            h16x4 cx[2][4];
#pragma unroll
            for (int rr = 0; rr < 2; ++rr)
#pragma unroll
                for (int j = 0; j < 4; ++j) cx[rr][j] = nx[rr][j];
            if (pass < 3) {
#pragma unroll
                for (int rr = 0; rr < 2; ++rr) { const int row = row0 + (pass + 1) * 16 + wave * 2 + rr;
#pragma unroll
                    for (int j = 0; j < 4; ++j) nx[rr][j] = *(const h16x4*)(x + (size_t)row * DM + 4 * lane + 256 * j); } }
#pragma unroll
            for (int rr = 0; rr < 2; ++rr) { const int lr = wave * 2 + rr, row = row0 + pass * 16 + lr;
                xh_t* xr = x + (size_t)row * DM + 4 * lane;
                f32x4 v[4]; float ss = 0.f;
#pragma unroll
                for (int j = 0; j < 4; ++j) { v[j] = __builtin_convertvector(cx[rr][j], f32x4);
                    ss += (v[j].x * v[j].x + v[j].y * v[j].y) + (v[j].z * v[j].z + v[j].w * v[j].w); }
                const float rstd = rsqrtf(wave_sum(ss, lane) * (1.0f / DM) + EPS);
                u32x2* ho = (u32x2*)(hb + (size_t)row * DM) + lane;
#pragma unroll
                for (int j = 0; j < 4; ++j) { const f32x4 Gv = *(const LAS f32x4*)(GS + 4 * lane + 256 * j), Sv = *(const LAS f32x4*)(GS + DM + 4 * lane + 256 * j);
                    const f32x4 h = v[j] * rstd * Gv + Sv;
                    u32x2 o; o.x = pk2(h.x, h.y); o.y = pk2(h.z, h.w); ho[64 * j] = o;
                    *(LAS f32x4*)(Hf + lr * HP + 4 * lane + 256 * j) = h; } }
            __syncthreads();
            { f32x4 acc[3];
#pragma unroll
              for (int n = 0; n < 3; ++n) acc[n] = (f32x4){0.f, 0.f, 0.f, 0.f};
#pragma unroll
              for (int kk = 0; kk < 4; ++kk) { const LAS float* hp = Hf + r * HP + (wave * 4 + kk) * 32 + g * 8;
                  const f32x4 h0 = *(const LAS f32x4*)hp, h1 = *(const LAS f32x4*)(hp + 4);
                  u32x4 hi; hi.x = pk2(h0.x, h0.y); hi.y = pk2(h0.z, h0.w); hi.z = pk2(h1.x, h1.y); hi.w = pk2(h1.z, h1.w);
                  u32x4 lo; lo.x = pk2(h0.x - bflo(hi.x), h0.y - bfhi(hi.x)); lo.y = pk2(h0.z - bflo(hi.y), h0.w - bfhi(hi.y));
                  lo.z = pk2(h1.x - bflo(hi.z), h1.y - bfhi(hi.z)); lo.w = pk2(h1.z - bflo(hi.w), h1.w - bfhi(hi.w));
                  const bf16x8 ahi = __builtin_bit_cast(bf16x8, hi), alo = __builtin_bit_cast(bf16x8, lo);
#pragma unroll
                  for (int n = 0; n < 3; ++n) { acc[n] = __builtin_amdgcn_mfma_f32_16x16x32_bf16(ahi, wh[kk][n], acc[n], 0, 0, 0);
                      acc[n] = __builtin_amdgcn_mfma_f32_16x16x32_bf16(ahi, wl[kk][n], acc[n], 0, 0, 0);
                      acc[n] = __builtin_amdgcn_mfma_f32_16x16x32_bf16(alo, wh[kk][n], acc[n], 0, 0, 0); } }
#pragma unroll
              for (int n = 0; n < 3; ++n)
#pragma unroll
                  for (int q = 0; q < 4; ++q) part[(wave * 16 + 4 * g + q) * 48 + n * 16 + r] = acc[n][q]; }
            __syncthreads();
#pragma unroll
            for (int k = 0; k < 2; ++k) { const int idx = tid + 512 * k;
                if (idx < 16 * 48) { float sacc = 0.f;
#pragma unroll
                    for (int w = 0; w < 8; ++w) sacc += part[w * 768 + idx];
                    lgt[idx] = sacc + rbias[idx % 48]; } }
            __syncthreads();
            if (tid < 16) {
                const LAS float* lg = lgt + tid * 48;
                float gl[4];
#pragma unroll
                for (int i = 0; i < 4; ++i) gl[i] = lg[i];
                int gs = 0; float mx = gl[0];
#pragma unroll
                for (int i = 1; i < 4; ++i) if (gl[i] > mx) { mx = gl[i]; gs = i; }
                float den = 0.f;
#pragma unroll
                for (int i = 0; i < 4; ++i) den += __expf(gl[i] - mx);
                const float pg = 1.0f / den;
                float el[8];
#pragma unroll
                for (int i = 0; i < 8; ++i) el[i] = lg[4 + gs * 8 + i];
                int i1 = 0; float v1 = el[0];
#pragma unroll
                for (int i = 1; i < 8; ++i) if (el[i] > v1) { v1 = el[i]; i1 = i; }
                int i2 = -1; float v2 = 0.f;
#pragma unroll
                for (int i = 0; i < 8; ++i) if (i != i1 && (i2 < 0 || el[i] > v2)) { v2 = el[i]; i2 = i; }
                const float tt = __expf(v2 - v1);
                const float g1 = pg / (1.0f + tt), g2 = pg * tt / (1.0f + tt);
                const int e1 = gs * 8 + i1, e2 = gs * 8 + i2;
                const int rk1 = __hip_atomic_fetch_add(hist + e1, 1, __ATOMIC_RELAXED, __HIP_MEMORY_SCOPE_WORKGROUP), rk2 = __hip_atomic_fetch_add(hist + e2, 1, __ATOMIC_RELAXED, __HIP_MEMORY_SCOPE_WORKGROUP);
                LAS int* d = dec + (pass * 16 + tid) * 6;
                d[0] = e1; d[1] = e2; d[2] = rk1; d[3] = rk2; d[4] = __float_as_int(g1); d[5] = __float_as_int(g2);
            }
        }
        __syncthreads();
        { const int t2 = opaque_tid();
          if (t2 < NEXP) { const int hc = hist[t2]; base[t2] = hc ? (int)xb_add(ctl + CW_CNT + 64 * cidx + t2, (unsigned)hc) : 0; } }
        __syncthreads();
        if (tid < 64) { const LAS int* d = dec + tid * 6; const int row = row0 + tid, e1 = d[0], e2 = d[1];
            const int s1 = base[e1] + d[2], s2 = base[e2] + d[3];
            tokmeta[row * 2] = ((unsigned)e1 << 16) | (unsigned)s1; tokmeta[row * 2 + 1] = ((unsigned)e2 << 16) | (unsigned)s2;
            tokidx[(size_t)e1 * CAP + s1] = row; tokidx[(size_t)e2 * CAP + s2] = row;
            gates[(size_t)e1 * CAP + s1] = __int_as_float(d[4]); gates[(size_t)e2 * CAP + s2] = __int_as_float(d[5]); }
        __syncthreads();
    }
}

DI void kv_tile(const Params& p, unsigned char* ws, int j2, int tile, int lane) {
    const bf16_t* proj = (const bf16_t*)(ws + WS_PROJ); const bf16_t* wkv = (const bf16_t*)(ws + WS_WKV) + (size_t)j2 * 128 * 128;
    bf16_t* Kb = (bf16_t*)(ws + WS_K);
    const int r = lane & 15, g = lane >> 4, row = tile * 16 + r;
    const bf16_t* xr = proj + (size_t)row * DINP + PC_KVL + g * 8;
    float xv[4][8]; float ss = 0.f;
#pragma unroll
    for (int ks = 0; ks < 4; ++ks) { const u32x4 raw = *(const u32x4*)(xr + ks * 32);
        xv[ks][0] = bflo(raw.x); xv[ks][1] = bfhi(raw.x); xv[ks][2] = bflo(raw.y); xv[ks][3] = bfhi(raw.y); xv[ks][4] = bflo(raw.z); xv[ks][5] = bfhi(raw.z); xv[ks][6] = bflo(raw.w); xv[ks][7] = bfhi(raw.w);
#pragma unroll
        for (int i = 0; i < 8; ++i) ss += xv[ks][i] * xv[ks][i]; }
    ss += shx(ss, 16, lane); ss += shx(ss, 32, lane);
    const float rstd = rsqrtf(ss * (1.0f / 128.0f) + EPS);
    bf16x8 af[4];
#pragma unroll
    for (int ks = 0; ks < 4; ++ks) { const float* gn = p.kv_norm + (size_t)j2 * 128 + ks * 32 + g * 8; const f32x4 n0 = *(const f32x4*)gn, n1 = *(const f32x4*)(gn + 4);
        u32x4 w; w.x = pk2(xv[ks][0] * rstd * n0.x, xv[ks][1] * rstd * n0.y); w.y = pk2(xv[ks][2] * rstd * n0.z, xv[ks][3] * rstd * n0.w);
        w.z = pk2(xv[ks][4] * rstd * n1.x, xv[ks][5] * rstd * n1.y); w.w = pk2(xv[ks][6] * rstd * n1.z, xv[ks][7] * rstd * n1.w);
        af[ks] = __builtin_bit_cast(bf16x8, w); }
#pragma unroll
    for (int nt = 0; nt < 8; ++nt) {
        const bf16_t* wr_ = wkv + (size_t)(nt * 16 + r) * 128 + g * 8;
        f32x4 acc = (f32x4){0.f, 0.f, 0.f, 0.f};
#pragma unroll
        for (int ks = 0; ks < 4; ++ks) acc = __builtin_amdgcn_mfma_f32_16x16x32_bf16(*(const bf16x8*)(wr_ + ks * 32), af[ks], acc, 0, 0, 0);
        u32x2 o; o.x = pk2(acc[0], acc[1]); o.y = pk2(acc[2], acc[3]);
        *(u32x2*)(Kb + (size_t)row * 128 + nt * 16 + 4 * g) = o;
    }
}
struct SguOps { bf16x8 wf[4]; u32x2 uu[8]; f32x4 gn[8]; float bias; };
DI void sgu_load_ops(const Params& p, const bf16_t* proj, const bf16_t* wsb, int j2, int gch, int r0, int wave, int r, int g, int nks, SguOps& o) {
    const bf16_t* wrow = wsb + ((size_t)(j2 * 4 + gch) * 128 + wave * 16 + r) * 128 + g * 8;
#pragma unroll
    for (int ks = 0; ks < 4; ++ks) o.wf[ks] = *(const bf16x8*)(wrow + (ks < nks ? ks : 0) * 32);
    const int ii = wave * 16 + r; o.bias = p.b_s[(size_t)(j2 * 4 + gch) * 128 + ii];
    const bf16_t* urow = proj + (size_t)(r0 + ii) * DINP + PC_U + gch * 128 + 4 * g; const float* gp = p.sgu_norm + (size_t)j2 * 512 + gch * 128 + 4 * g;
#pragma unroll
    for (int ct = 0; ct < 8; ++ct) { o.uu[ct] = *(const u32x2*)(urow + ct * 16); o.gn[ct] = *(const f32x4*)(gp + ct * 16); }
}
DI void sgu_mix_store(const LAS bf16_t* vT, bf16_t* cat, int gch, int r0, int wave, int r, int g, int nks, const SguOps& o) {
    constexpr int VP = 136;
    f32x4 acc[8];
#pragma unroll
    for (int ct = 0; ct < 8; ++ct) acc[ct] = (f32x4){0.f, 0.f, 0.f, 0.f};
#pragma unroll
    for (int ks = 0; ks < 4; ++ks) if (ks < nks) {
#pragma unroll
        for (int ct = 0; ct < 8; ++ct) { const bf16x8 vf = *(const LAS bf16x8*)(vT + (ct * 16 + r) * VP + ks * 32 + g * 8);
            acc[ct] = __builtin_amdgcn_mfma_f32_16x16x32_bf16(vf, o.wf[ks], acc[ct], 0, 0, 0); } }
    bf16_t* orow = cat + (size_t)(r0 + wave * 16 + r) * DM + 512 + gch * 128 + 4 * g;
#pragma unroll
    for (int ct = 0; ct < 8; ++ct) { const f32x4 m = acc[ct] * o.gn[ct] + o.bias;
        u32x2 w; w.x = pk2(bflo(o.uu[ct].x) * m[0], bfhi(o.uu[ct].x) * m[1]); w.y = pk2(bflo(o.uu[ct].y) * m[2], bfhi(o.uu[ct].y) * m[3]);
        *(u32x2*)(orow + ct * 16) = w; }
}
DI void sgu_unit(const Params& p, unsigned char* ws, LAS unsigned char* lds, int j2, int unit) {
    const int tid = opaque_tid(), lane = tid & 63, wave = __builtin_amdgcn_readfirstlane(tid >> 6);
    const bf16_t* proj = (const bf16_t*)(ws + WS_PROJ); bf16_t* cat = (bf16_t*)(ws + WS_CAT);
    const bf16_t* wsb = (const bf16_t*)(ws + WS_WS);
    const int gch0 = (unit & 1) * 2, bn = unit >> 1;
    const int r0 = bn * 128;
    constexpr int VP = 136;
    LAS bf16_t* vT = (LAS bf16_t*)lds;
    const int r = lane & 15, g = lane >> 4;
    u32x4 raw[16];
    { const bf16_t* vp = proj + (size_t)(r0 + wave * 16 + g) * DINP + PC_V + r * 8;
#pragma unroll
      for (int it = 0; it < 16; ++it) raw[it] = *(const u32x4*)(vp + (size_t)((it >> 2) * 4) * DINP + (((it & 3) + gch0) & 3) * 128); }
    const int nks = (wave < 4) ? 2 : 4;
    SguOps oa; sgu_load_ops(p, proj, wsb, j2, gch0, r0, wave, r, g, nks, oa);
    float mean[4], rs[4];
#pragma unroll
    for (int rg = 0; rg < 4; ++rg) { float s1 = 0.f, s2 = 0.f;
#pragma unroll
        for (int q = 0; q < 4; ++q) { const u32x4 w = raw[rg * 4 + q];
            const float f0 = bflo(w.x), f1 = bfhi(w.x), f2 = bflo(w.y), f3 = bfhi(w.y), f4 = bflo(w.z), f5 = bfhi(w.z), f6 = bflo(w.w), f7 = bfhi(w.w);
            s1 += ((f0 + f1) + (f2 + f3)) + ((f4 + f5) + (f6 + f7));
            s2 += ((f0 * f0 + f1 * f1) + (f2 * f2 + f3 * f3)) + ((f4 * f4 + f5 * f5) + (f6 * f6 + f7 * f7)); }
#pragma unroll
        for (int o = 1; o < 16; o <<= 1) { s1 += shx(s1, o, lane); s2 += shx(s2, o, lane); }
        mean[rg] = s1 * (1.0f / 512.0f); rs[rg] = rsqrtf(fmaxf(s2 * (1.0f / 512.0f) - mean[rg] * mean[rg], 0.f) + EPS); }
#pragma unroll
    for (int gi = 0; gi < 2; ++gi)
#pragma unroll
        for (int rg = 0; rg < 4; ++rg) { u32x4 w = raw[rg * 4 + gi];
            asm volatile("" : "+v"(w));
            const float f[8] = {bflo(w.x), bfhi(w.x), bflo(w.y), bfhi(w.y), bflo(w.z), bfhi(w.z), bflo(w.w), bfhi(w.w)};
            const int jr = wave * 16 + rg * 4 + g;
#pragma unroll
            for (int e = 0; e < 8; ++e) vT[gi * (128 * VP) + (r * 8 + e) * VP + jr] = (bf16_t)(pk2((f[e] - mean[rg]) * rs[rg], 0.f) & 0xffffu); }
    __syncthreads();
    SguOps ob; sgu_load_ops(p, proj, wsb, j2, gch0 + 1, r0, wave, r, g, nks, ob);
    sgu_mix_store(vT, cat, gch0, r0, wave, r, g, nks, oa);
    sgu_mix_store(vT + 128 * VP, cat, gch0 + 1, r0, wave, r, g, nks, ob);
    __syncthreads();
}

DI unsigned okey(float f) { const unsigned u = __float_as_uint(f); return u ^ ((unsigned)((int)u >> 31) | 0x80000000u); }
DI int cnt_ge8(unsigned k0, unsigned k1, unsigned k2, unsigned k3, unsigned k4, unsigned k5, unsigned k6, unsigned k7, unsigned cand) {
    int c, t1, t2, t3, t4, t5, t6, t7; unsigned long long m0, m1, m2, m3, m4, m5, m6, m7;
    asm("v_cmp_ge_u32_e64 %8, %16, %24\n\tv_cmp_ge_u32_e64 %9, %17, %24\n\tv_cmp_ge_u32_e64 %10, %18, %24\n\tv_cmp_ge_u32_e64 %11, %19, %24\n\t"
        "v_cmp_ge_u32_e64 %12, %20, %24\n\tv_cmp_ge_u32_e64 %13, %21, %24\n\tv_cmp_ge_u32_e64 %14, %22, %24\n\tv_cmp_ge_u32_e64 %15, %23, %24\n\t"
        "s_bcnt1_i32_b64 %0, %8\n\ts_bcnt1_i32_b64 %1, %9\n\ts_bcnt1_i32_b64 %2, %10\n\ts_bcnt1_i32_b64 %3, %11\n\t"
        "s_bcnt1_i32_b64 %4, %12\n\ts_bcnt1_i32_b64 %5, %13\n\ts_bcnt1_i32_b64 %6, %14\n\ts_bcnt1_i32_b64 %7, %15\n\t"
        "s_add_i32 %0, %0, %1\n\ts_add_i32 %2, %2, %3\n\ts_add_i32 %4, %4, %5\n\ts_add_i32 %6, %6, %7\n\ts_add_i32 %0, %0, %2\n\ts_add_i32 %4, %4, %6\n\ts_add_i32 %0, %0, %4"
        : "=&s"(c), "=&s"(t1), "=&s"(t2), "=&s"(t3), "=&s"(t4), "=&s"(t5), "=&s"(t6), "=&s"(t7),
          "=&s"(m0), "=&s"(m1), "=&s"(m2), "=&s"(m3), "=&s"(m4), "=&s"(m5), "=&s"(m6), "=&s"(m7)
        : "v"(k0), "v"(k1), "v"(k2), "v"(k3), "v"(k4), "v"(k5), "v"(k6), "v"(k7), "v"(cand)
        : "scc");
    return c;
}
template <int NS, class IdxF>
DI void topk_search_write(const unsigned (&key)[NS], LAS unsigned short* il, int lane, const IdxF& IDX, unsigned lo) {
    unsigned prefix = 0u;
#pragma unroll 1
    for (int bit = 31; bit >= 0; --bit) {
        const unsigned cand = prefix | (1u << bit);
        if (cand <= lo) { prefix = cand; continue; }
        int cnt = 0;
#pragma unroll
        for (int i0 = 0; i0 < NS; i0 += 8)
            cnt += cnt_ge8(key[i0], key[i0 + 1], key[i0 + 2], key[i0 + 3], key[i0 + 4], key[i0 + 5], key[i0 + 6], key[i0 + 7], cand);
        if (cnt >= 256) prefix = cand;
        if (cnt == 256) break;
    }
    int cgt = 0;
#pragma unroll
    for (int i = 0; i < NS; ++i) cgt += __builtin_popcountll(__ballot(key[i] > prefix));
    int rem = 256 - cgt, wpos = 0;
    const unsigned long long ltmask = (1ull << lane) - 1ull;
#pragma unroll
    for (int i = 0; i < NS; ++i) {
        const bool tie = (key[i] == prefix);
        const unsigned long long tb = __ballot(tie);
        const int before = __builtin_popcountll(tb & ltmask);
        const bool sel = (key[i] > prefix) || (tie && before < rem);
        rem -= __builtin_popcountll(tb);
        const unsigned long long sb = __ballot(sel);
        if (sel) il[wpos + __builtin_popcountll(sb & ltmask)] = (unsigned short)IDX(i);
        wpos += __builtin_popcountll(sb);
    }
}
template <int NS>
DI void select_topk(LAS float* srow, int nsl, LAS unsigned short* il, int lane) {
    unsigned key[NS];
#pragma unroll
    for (int i = 0; i < NS; ++i) key[i] = (i < nsl) ? okey(srow[i * 64 + lane]) : 0u;
    if (NS >= 16) {
        const int nk = nsl * 64; int r0 = (64 * 320 + nk - 1) / nk + 2; r0 = r0 > 64 ? 64 : r0;
        unsigned t0 = 0u;
#pragma unroll 1
        for (int bit = 31; bit >= 12; --bit) { const unsigned cand = t0 | (1u << bit); if (__builtin_popcountll(__ballot(key[0] >= cand)) >= r0) t0 = cand; }
        int cnt0 = 0;
#pragma unroll
        for (int i0 = 0; i0 < NS; i0 += 8) cnt0 += cnt_ge8(key[i0], key[i0 + 1], key[i0 + 2], key[i0 + 3], key[i0 + 4], key[i0 + 5], key[i0 + 6], key[i0 + 7], t0);
        if (cnt0 >= 256 && cnt0 <= 512) {
            LAS unsigned* ck = (LAS unsigned*)srow; LAS unsigned* ci = ck + 1024;
            const unsigned long long ltmask = (1ull << lane) - 1ull; int wpos = 0;
            asm volatile("s_waitcnt lgkmcnt(0)" ::: "memory");
#pragma unroll
            for (int i = 0; i < NS; ++i) { const bool c = key[i] >= t0; const unsigned long long cb = __ballot(c);
                if (c) { const int pos = wpos + __builtin_popcountll(cb & ltmask); ck[pos] = key[i]; ci[pos] = (unsigned)(i * 64 + lane); }
                wpos += __builtin_popcountll(cb); }
            asm volatile("s_waitcnt lgkmcnt(0)" ::: "memory");
            unsigned k8[8], i8[8];
#pragma unroll
            for (int j = 0; j < 8; ++j) { const bool v = (j * 64 + lane) < cnt0; k8[j] = v ? ck[j * 64 + lane] : 0u; i8[j] = v ? ci[j * 64 + lane] : 0u; }
            topk_search_write<8>(k8, il, lane, [&](int j) { return i8[j]; }, t0);
            return;
        }
    }
    topk_search_write<NS>(key, il, lane, [&](int i) { return (unsigned)(i * 64 + lane); }, 0u);
}
template <int NT>
DI void attn_query(const bf16_t* proj, const char* KVb, bf16_t* cat, LAS unsigned char* vbuf, const LAS unsigned short* il, int b, int tq, int lane) {
    constexpr int W = NT * 16, NCH = NT / 4;
    const int r = lane & 15, g = lane >> 4, hh = r & 7, tok = b * SEQ + tq;
    const float slope2 = __builtin_amdgcn_exp2f(-(float)(hh + 1)) * LOG2E;
    const float QS = 0.125f * LOG2E;
    asm volatile("s_waitcnt lgkmcnt(0)" ::: "memory");
#pragma unroll
    for (int c = 0; c < 2; ++c) if (c < NCH)
#pragma unroll
        for (int i = 0; i < 8; ++i) { const int rr = lane >> 3; const int key = il[c * 64 + i * 8 + rr];
            const char* gp = KVb + (size_t)key * 256 + 128 + (((lane & 7) ^ ((rr >> 1) & 3)) << 4);
            __builtin_amdgcn_global_load_lds((const unsigned*)gp, (LAS unsigned*)(vbuf + c * 8192 + i * 1024), 16, 0, 0); }
    bf16x8 qf[2];
    { const bf16_t* qrow = proj + (size_t)tok * DINP + PC_Q + hh * 64 + g * 8;
#pragma unroll
      for (int ks = 0; ks < 2; ++ks) { const u32x4 raw = *(const u32x4*)(qrow + ks * 32); u32x4 w;
        w.x = pk2(bflo(raw.x) * QS, bfhi(raw.x) * QS); w.y = pk2(bflo(raw.y) * QS, bfhi(raw.y) * QS); w.z = pk2(bflo(raw.z) * QS, bfhi(raw.z) * QS); w.w = pk2(bflo(raw.w) * QS, bfhi(raw.w) * QS);
        qf[ks] = __builtin_bit_cast(bf16x8, w); } }
    f32x4 st[NT];
#pragma unroll
    for (int hb = 0; hb < NT; hb += 8) {
        bf16x8 kf[8][2];
#pragma unroll
        for (int t8 = 0; t8 < 8; ++t8) if (hb + t8 < NT) { const int key = il[(hb + t8) * 16 + r];
            const char* kp = KVb + (size_t)key * 256 + g * 16; kf[t8][0] = *(const bf16x8*)kp; kf[t8][1] = *(const bf16x8*)(kp + 64); }
#pragma unroll
        for (int t8 = 0; t8 < 8; ++t8) if (hb + t8 < NT) {
            st[hb + t8] = __builtin_amdgcn_mfma_f32_16x16x32_bf16(kf[t8][0], qf[0], (f32x4){0.f, 0.f, 0.f, 0.f}, 0, 0, 0);
            st[hb + t8] = __builtin_amdgcn_mfma_f32_16x16x32_bf16(kf[t8][1], qf[1], st[hb + t8], 0, 0, 0); }
    }
    const float qpos = (float)tq;
    float mx = -INFINITY;
#pragma unroll
    for (int tt = 0; tt < NT; ++tt) { const u32x2 kk = *(const LAS u32x2*)(il + tt * 16 + 4 * g);
        const float k0 = (float)(kk.x & 0xffffu), k1 = (float)(kk.x >> 16), k2 = (float)(kk.y & 0xffffu), k3 = (float)(kk.y >> 16);
        st[tt][0] -= slope2 * fabsf(qpos - k0); st[tt][1] -= slope2 * fabsf(qpos - k1); st[tt][2] -= slope2 * fabsf(qpos - k2); st[tt][3] -= slope2 * fabsf(qpos - k3);
        mx = fmaxf(fmaxf(mx, fmaxf(st[tt][0], st[tt][1])), fmaxf(st[tt][2], st[tt][3])); }
    mx = fmaxf(mx, shx(mx, 16, lane)); mx = fmaxf(mx, shx(mx, 32, lane));
    float lsum = 0.f;
    bf16x8 pf[NT / 2];
#pragma unroll
    for (int T = 0; T < NT / 2; ++T) { float e[8];
#pragma unroll
        for (int j = 0; j < 4; ++j) { e[j] = __builtin_amdgcn_exp2f(st[2 * T][j] - mx); e[4 + j] = __builtin_amdgcn_exp2f(st[2 * T + 1][j] - mx); }
        lsum += ((e[0] + e[1]) + (e[2] + e[3])) + ((e[4] + e[5]) + (e[6] + e[7]));
        u32x4 pw; pw.x = pk2(e[0], e[1]); pw.y = pk2(e[2], e[3]); pw.z = pk2(e[4], e[5]); pw.w = pk2(e[6], e[7]);
        pf[T] = __builtin_bit_cast(bf16x8, pw); }
    lsum += shx(lsum, 16, lane); lsum += shx(lsum, 32, lane);
    f32x4 o[4];
#pragma unroll
    for (int dt = 0; dt < 4; ++dt) o[dt] = (f32x4){0.f, 0.f, 0.f, 0.f};
    const int tq_ = (r >> 2), tp_ = (r & 3);
    const LAS unsigned char* vbase[4];
    { const int k0_ = 4 * g + tq_;
#pragma unroll
      for (int dt = 0; dt < 4; ++dt) vbase[dt] = vbuf + (k0_ >> 3) * 1024 + (k0_ & 7) * 128 + (((dt * 2 + (tp_ >> 1)) ^ (((k0_ & 7) >> 1) & 3)) << 4) + (tp_ & 1) * 8; }
#pragma unroll
    for (int half = 0; half < 2; ++half) if (half * 2 < NCH) {
        if (half == 1) {
            asm volatile("s_waitcnt lgkmcnt(0)" ::: "memory");
#pragma unroll
            for (int c = 0; c < 2; ++c) if (2 + c < NCH)
#pragma unroll
                for (int i = 0; i < 8; ++i) { const int rr = lane >> 3; const int key = il[(2 + c) * 64 + i * 8 + rr];
                    const char* gp = KVb + (size_t)key * 256 + 128 + (((lane & 7) ^ ((rr >> 1) & 3)) << 4);
                    __builtin_amdgcn_global_load_lds((const unsigned*)gp, (LAS unsigned*)(vbuf + c * 8192 + i * 1024), 16, 0, 0); }
        }
        asm volatile("s_waitcnt vmcnt(0)" ::: "memory");
#pragma unroll
        for (int c = 0; c < 2; ++c) if (half * 2 + c < NCH)
#pragma unroll
            for (int pr = 0; pr < 2; ++pr) { const int T = (half * 2 + c) * 2 + pr;
#pragma unroll
                for (int dt = 0; dt < 4; ++dt) {
                    const LAS unsigned char* a1 = vbase[dt] + c * 8192 + pr * 4096;
                    const s16x4 v1 = __builtin_amdgcn_ds_read_tr16_b64_v4i16((LAS s16x4*)a1), v2 = __builtin_amdgcn_ds_read_tr16_b64_v4i16((LAS s16x4*)(a1 + 2048));
                    const bf16x8 vf = {v1[0], v1[1], v1[2], v1[3], v2[0], v2[1], v2[2], v2[3]};
                    o[dt] = __builtin_amdgcn_mfma_f32_16x16x32_bf16(vf, pf[T], o[dt], 0, 0, 0); } }
    }
    const float inv = 1.0f / lsum;
    if (r < 8) { const __amdgpu_buffer_rsrc_t crs = __builtin_amdgcn_make_buffer_rsrc(cat, 0, 0x7fffffff, 0x00020000);
        const unsigned ob = ((unsigned)tok * (unsigned)DM + (unsigned)(r * 64 + 4 * g)) * 2u;
#pragma unroll
        for (int dt = 0; dt < 4; ++dt) { u32x2 ov; ov.x = pk2(o[dt][0] * inv, o[dt][1] * inv); ov.y = pk2(o[dt][2] * inv, o[dt][3] * inv); __builtin_amdgcn_raw_buffer_store_b64(ov, crs, (int)(ob + dt * 32u), 0, 16); } }
}
DI void attn16_vdma(const char* KVb, LAS unsigned char* vbuf, const LAS unsigned short* il, int chunk, int buf, int lane) {
#pragma unroll
    for (int i = 0; i < 8; ++i) { const int rr = lane >> 3; const int key = il[chunk * 64 + i * 8 + rr];
        const char* gp = KVb + (size_t)key * 256 + 128 + (((lane & 7) ^ ((rr >> 1) & 3)) << 4);
        __builtin_amdgcn_global_load_lds((const unsigned*)gp, (LAS unsigned*)(vbuf + buf * 8192 + i * 1024), 16, 0, 0); }
}
DI void attn16_loadq(const bf16_t* proj, int tok, u32x4 (&qraw)[2], int lane) {
    const int r = lane & 15, g = lane >> 4, hh = r & 7;
    const bf16_t* qrow = proj + (size_t)tok * DINP + PC_Q + hh * 64 + g * 8;
    qraw[0] = *(const u32x4*)qrow; qraw[1] = *(const u32x4*)(qrow + 32);
}
DI void attn16_load(const char* KVb, const LAS unsigned short* il, bf16x8 (&kf)[16][2], int lane) {
#pragma unroll
    for (int tt = 0; tt < 16; ++tt)
#pragma unroll
        for (int i = 0; i < 2; ++i) { const int key = il[tt * 16 + 8 * i + (lane >> 3)];
            kf[tt][i] = *(const bf16x8*)(KVb + (size_t)key * 256 + (lane & 7) * 16); }
}
DI void attn16_kfrag(LAS unsigned char* stg, const bf16x8 (&raw)[2], bf16x8 (&fr)[2], int lane) {
    const int r = lane & 15, g = lane >> 4;
#pragma unroll
    for (int i = 0; i < 2; ++i) { const int rr = 8 * i + (lane >> 3); *(LAS bf16x8*)(stg + rr * 128 + (((lane & 7) ^ (rr & 7)) << 4)) = raw[i]; }
#pragma unroll
    for (int ks = 0; ks < 2; ++ks) fr[ks] = *(const LAS bf16x8*)(stg + r * 128 + (((ks * 4 + g) ^ (r & 7)) << 4));
}
DI void attn16_compute(const bf16_t* proj, const char* KVb, bf16_t* cat, LAS unsigned char* vbuf, LAS unsigned char* kstg, const LAS unsigned short* il, int b, int tq, bf16x8 (&kf)[16][2], u32x4 (&qraw)[2],
                       const LAS unsigned short* nil, int ntok, int lane) {
    const int r = lane & 15, g = lane >> 4, hh = r & 7, tok = b * SEQ + tq;
    const float slope2 = __builtin_amdgcn_exp2f(-(float)(hh + 1)) * LOG2E;
    const float QS = 0.125f * LOG2E;
    bf16x8 qf[2];
#pragma unroll
    for (int ks = 0; ks < 2; ++ks) { const u32x4 raw = qraw[ks]; u32x4 w;
        w.x = pk2(bflo(raw.x) * QS, bfhi(raw.x) * QS); w.y = pk2(bflo(raw.y) * QS, bfhi(raw.y) * QS); w.z = pk2(bflo(raw.z) * QS, bfhi(raw.z) * QS); w.w = pk2(bflo(raw.w) * QS, bfhi(raw.w) * QS);
        qf[ks] = __builtin_bit_cast(bf16x8, w); }
    f32x4 st[16];
#pragma unroll
    for (int tt = 0; tt < 16; ++tt) { bf16x8 fr[2]; attn16_kfrag(kstg, kf[tt], fr, lane);
        st[tt] = __builtin_amdgcn_mfma_f32_16x16x32_bf16(fr[0], qf[0], (f32x4){0.f, 0.f, 0.f, 0.f}, 0, 0, 0);
        st[tt] = __builtin_amdgcn_mfma_f32_16x16x32_bf16(fr[1], qf[1], st[tt], 0, 0, 0); }
    if (nil) attn16_load(KVb, nil, kf, lane);
    const float qpos = (float)tq;
    float mx = -INFINITY;
#pragma unroll
    for (int tt = 0; tt < 16; ++tt) { const u32x2 kk = *(const LAS u32x2*)(il + tt * 16 + 4 * g);
        const float k0 = (float)(kk.x & 0xffffu), k1 = (float)(kk.x >> 16), k2 = (float)(kk.y & 0xffffu), k3 = (float)(kk.y >> 16);
        st[tt][0] -= slope2 * fabsf(qpos - k0); st[tt][1] -= slope2 * fabsf(qpos - k1); st[tt][2] -= slope2 * fabsf(qpos - k2); st[tt][3] -= slope2 * fabsf(qpos - k3);
        mx = fmaxf(fmaxf(mx, fmaxf(st[tt][0], st[tt][1])), fmaxf(st[tt][2], st[tt][3])); }
    mx = fmaxf(mx, shx(mx, 16, lane)); mx = fmaxf(mx, shx(mx, 32, lane));
    float lsum = 0.f;
    bf16x8 pf[8];
#pragma unroll
    for (int T = 0; T < 8; ++T) { float e[8];
#pragma unroll
        for (int j = 0; j < 4; ++j) { e[j] = __builtin_amdgcn_exp2f(st[2 * T][j] - mx); e[4 + j] = __builtin_amdgcn_exp2f(st[2 * T + 1][j] - mx); }
        lsum += ((e[0] + e[1]) + (e[2] + e[3])) + ((e[4] + e[5]) + (e[6] + e[7]));
        u32x4 pw; pw.x = pk2(e[0], e[1]); pw.y = pk2(e[2], e[3]); pw.z = pk2(e[4], e[5]); pw.w = pk2(e[6], e[7]);
        pf[T] = __builtin_bit_cast(bf16x8, pw); }
    lsum += shx(lsum, 16, lane); lsum += shx(lsum, 32, lane);
    if (nil) attn16_loadq(proj, ntok, qraw, lane);
    f32x4 o[4];
#pragma unroll
    for (int dt = 0; dt < 4; ++dt) o[dt] = (f32x4){0.f, 0.f, 0.f, 0.f};
    const int tq_ = (r >> 2), tp_ = (r & 3);
    const LAS unsigned char* vbase[4];
    { const int k0_ = 4 * g + tq_;
#pragma unroll
      for (int dt = 0; dt < 4; ++dt) vbase[dt] = vbuf + (k0_ >> 3) * 1024 + (k0_ & 7) * 128 + (((dt * 2 + (tp_ >> 1)) ^ (((k0_ & 7) >> 1) & 3)) << 4) + (tp_ & 1) * 8; }
#pragma unroll
    for (int half = 0; half < 2; ++half) {
        if (half == 1) {
            asm volatile("s_waitcnt lgkmcnt(0)" ::: "memory");
            attn16_vdma(KVb, vbuf, il, 2, 0, lane); attn16_vdma(KVb, vbuf, il, 3, 1, lane);
        }
        asm volatile("s_waitcnt vmcnt(0)" ::: "memory");
#pragma unroll
        for (int c = 0; c < 2; ++c)
#pragma unroll
            for (int pr = 0; pr < 2; ++pr) { const int T = (half * 2 + c) * 2 + pr;
#pragma unroll
                for (int dt = 0; dt < 4; ++dt) {
                    const LAS unsigned char* a1 = vbase[dt] + c * 8192 + pr * 4096;
                    const s16x4 v1 = __builtin_amdgcn_ds_read_tr16_b64_v4i16((LAS s16x4*)a1), v2 = __builtin_amdgcn_ds_read_tr16_b64_v4i16((LAS s16x4*)(a1 + 2048));
                    const bf16x8 vf = {v1[0], v1[1], v1[2], v1[3], v2[0], v2[1], v2[2], v2[3]};
                    o[dt] = __builtin_amdgcn_mfma_f32_16x16x32_bf16(vf, pf[T], o[dt], 0, 0, 0); } }
    }
    const float inv = 1.0f / lsum;
    if (r < 8) { const __amdgpu_buffer_rsrc_t crs = __builtin_amdgcn_make_buffer_rsrc(cat, 0, 0x7fffffff, 0x00020000);
        const unsigned ob = ((unsigned)tok * (unsigned)DM + (unsigned)(r * 64 + 4 * g)) * 2u;
#pragma unroll
        for (int dt = 0; dt < 4; ++dt) { u32x2 ov; ov.x = pk2(o[dt][0] * inv, o[dt][1] * inv); ov.y = pk2(o[dt][2] * inv, o[dt][3] * inv); __builtin_amdgcn_raw_buffer_store_b64(ov, crs, (int)(ob + dt * 32u), 0, 16); } }
}
DI void attn_unit(const Params& p, unsigned char* ws, LAS unsigned char* lds, int b, int qt, unsigned* qctr, int qadd, volatile LAS int* qslot, unsigned* pnl) {
    const int tid = opaque_tid(); int lane = tid & 63; const int wave = __builtin_amdgcn_readfirstlane(tid >> 6);
    int qnext = 0;
    if (tid == 0) qnext = (int)__hip_atomic_fetch_add(qctr, 1u, __ATOMIC_RELAXED, __HIP_MEMORY_SCOPE_AGENT) + qadd;
    const bf16_t* proj = (const bf16_t*)(ws + WS_PROJ); const bf16_t* Kb = (const bf16_t*)(ws + WS_K);
    bf16_t* cat = (bf16_t*)(ws + WS_CAT);
    const int r = lane & 15, g = lane >> 4;
    const int t0 = qt * 16, nk = ((t0 >> 6) + 1) * 64, tok0 = b * SEQ + t0;
    LAS float* sc = (LAS float*)lds;
    for (int rep_ = 0; rep_ < ((PROBE_MASK & (1 << 12)) ? 2 : 1); ++rep_)
    if (nk > 256) {
        const bf16_t* qrow = proj + (size_t)(tok0 + r) * DINP;
        bf16x8 qf[8][2]; float wv[8];
#pragma unroll
        for (int h = 0; h < 8; ++h)
#pragma unroll
            for (int ks = 0; ks < 2; ++ks) qf[h][ks] = *(const bf16x8*)(qrow + PC_QI + h * 64 + ks * 32 + g * 8);
        { const u32x4 wr_ = *(const u32x4*)(qrow + PC_WI); const float C = 0.35355339059f * 0.125f;
          wv[0] = bflo(wr_.x) * C; wv[1] = bfhi(wr_.x) * C; wv[2] = bflo(wr_.y) * C; wv[3] = bfhi(wr_.y) * C; wv[4] = bflo(wr_.z) * C; wv[5] = bfhi(wr_.z) * C; wv[6] = bflo(wr_.w) * C; wv[7] = bfhi(wr_.w) * C; }
        const bf16_t* kbase = proj + (size_t)(b * SEQ + r) * DINP + PC_KI + g * 8;
        bf16x8 kn0 = *(const bf16x8*)(kbase + (size_t)(wave * 16) * DINP), kn1 = *(const bf16x8*)(kbase + (size_t)(wave * 16) * DINP + 32);
        for (int kt = wave; kt < nk / 16; kt += 8) {
            const bf16x8 k0 = kn0, k1 = kn1;
            { const int ktn = (kt + 8 < nk / 16) ? kt + 8 : kt;
              const bf16_t* krow = kbase + (size_t)(ktn * 16) * DINP; kn0 = *(const bf16x8*)krow; kn1 = *(const bf16x8*)(krow + 32); }
            f32x4 s = (f32x4){0.f, 0.f, 0.f, 0.f};
#pragma unroll
            for (int h = 0; h < 8; ++h) { f32x4 a = __builtin_amdgcn_mfma_f32_16x16x32_bf16(k0, qf[h][0], (f32x4){0.f, 0.f, 0.f, 0.f}, 0, 0, 0);
                a = __builtin_amdgcn_mfma_f32_16x16x32_bf16(k1, qf[h][1], a, 0, 0, 0);
#pragma unroll
                for (int q = 0; q < 4; ++q) s[q] += wv[h] * fmaxf(a[q], 0.f); }
            *(LAS f32x4*)(sc + r * SC_PITCH + kt * 16 + 4 * g) = s;
        }
    }
    if (tid == 0) *qslot = qnext;
    __syncthreads();
    asm volatile("" : "+v"(lane));
    LAS unsigned short* ilw = (LAS unsigned short*)(lds + IDX_OFF) + wave * 512;
    LAS unsigned char* vbuf = lds + wave * (2 * SC_PITCH * 4);
    const char* KVb = (const char*)Kb + (size_t)b * SEQ * 256;
    const int tqa = t0 + wave * 2;
    if (nk > 256) {
        const int nsl = nk >> 6;
        LAS float* srow = sc + (wave * 2) * SC_PITCH;
        bf16x8 kf[16][2]; u32x4 qraw[2];
        LAS unsigned char* kstg = lds + KSTG_OFF + wave * 2048;
#define SELECT(SROW, IL) do { if (nsl <= 8) select_topk<8>(SROW, nsl, IL, lane); else if (nsl <= 16) select_topk<16>(SROW, nsl, IL, lane); \
            else if (nsl <= 24) select_topk<24>(SROW, nsl, IL, lane); else select_topk<32>(SROW, nsl, IL, lane); } while (0)
        SELECT(srow, ilw);
        if (PROBE_MASK & (1 << 13)) { SELECT(srow, ilw); SELECT(srow + SC_PITCH, ilw + 256); }
        LDS_WAIT(); asm volatile("" ::: "memory");
        attn16_loadq(proj, b * SEQ + tqa, qraw, lane); attn16_load(KVb, ilw, kf, lane);
        attn16_vdma(KVb, vbuf, ilw, 0, 0, lane);
        SELECT(srow + SC_PITCH, ilw + 256);
#undef SELECT
        LDS_WAIT(); asm volatile("" ::: "memory");
        attn16_vdma(KVb, vbuf, ilw, 1, 1, lane);
        attn16_compute(proj, KVb, cat, vbuf, kstg, ilw, b, tqa, kf, qraw, (PROBE_MASK & ((1 << 14) | (1 << 18))) ? nullptr : ilw + 256, b * SEQ + tqa + 1, lane);
        asm volatile("s_waitcnt lgkmcnt(0)" ::: "memory");
#pragma unroll 1
        for (int rep_ = 0; rep_ < ((PROBE_MASK & (1 << 14)) ? 2 : 1); ++rep_) {
            if (PROBE_MASK & ((1 << 14) | (1 << 18))) { asm volatile("s_waitcnt lgkmcnt(0)" ::: "memory"); attn16_loadq(proj, b * SEQ + tqa + 1, qraw, lane); attn16_load(KVb, ilw + 256, kf, lane); }
            attn16_vdma(KVb, vbuf, ilw + 256, 0, 0, lane); attn16_vdma(KVb, vbuf, ilw + 256, 1, 1, lane);
            attn16_compute(proj, KVb, cat, vbuf, kstg, ilw + 256, b, tqa + 1, kf, qraw, nullptr, 0, lane); }
        if (PROBE_MASK & ((1 << 19) | (1 << 20))) {
                const LAS unsigned short* ilq = ilw + 256;
#pragma unroll 1
                for (int tt = 0; tt < 16; ++tt) { u32x4 x0, x1;
                    if (PROBE_MASK & (1 << 19)) { const int key = (ilq[tt * 16 + r] + 1024) & 2047; const char* kp = KVb + (size_t)key * 256 + g * 16;
                        x0 = *(const u32x4*)kp; x1 = *(const u32x4*)(kp + 64); }
                    else { const int k0 = (ilq[tt * 16 + (lane >> 3)] + 1024) & 2047, k1 = (ilq[tt * 16 + 8 + (lane >> 3)] + 1024) & 2047;
                        x0 = *(const u32x4*)(KVb + (size_t)k0 * 256 + (lane & 7) * 16); x1 = *(const u32x4*)(KVb + (size_t)k1 * 256 + (lane & 7) * 16); }
                    asm volatile("" :: "v"(x0), "v"(x1)); } }
    } else {
        for (int qq = 0; qq < 2; ++qq) {
            LAS unsigned short* il = ilw + qq * 256;
            for (int k = lane; k < nk; k += 64) il[k] = (unsigned short)k;
        }
        LDS_WAIT(); asm volatile("" ::: "memory");
        for (int qq = 0; qq < 2; ++qq) {
            const LAS unsigned short* il = ilw + qq * 256;
            if (nk == 256) attn_query<16>(proj, KVb, cat, vbuf, il, b, tqa + qq, lane);
            else if (nk == 192) attn_query<12>(proj, KVb, cat, vbuf, il, b, tqa + qq, lane);
            else if (nk == 128) attn_query<8>(proj, KVb, cat, vbuf, il, b, tqa + qq, lane);
            else attn_query<4>(proj, KVb, cat, vbuf, il, b, tqa + qq, lane);
        }
    }
    asm volatile("s_waitcnt vmcnt(0) lgkmcnt(0)" ::: "memory");
    __syncthreads();
    if (tid == 0) (void)__hip_atomic_fetch_add(pnl + 64 * ((b * SEQ + t0) >> 8), 1u, __ATOMIC_RELAXED, __HIP_MEMORY_SCOPE_AGENT);
}

DI void a45_phase(const Params& p, LAS unsigned char* lds, int G, int bid, int call) {
    unsigned char* ws = opaque_ws(p.ws);
    const int b = bid & 7, nb = (G + 7 - b) >> 3;
    unsigned* qctr = (unsigned*)(ws + WS_CTL) + CW_A45Q + (size_t)(call * 8 + b) * 64;
    volatile LAS int* qs = (volatile LAS int*)(lds + QSLOT_OFF);
    int u = bid >> 3, it = 0;
    unsigned* pnl = (unsigned*)(ws + WS_CTL) + CW_PNL + (size_t)call * 64 * 64;
    while (u < 128) { attn_unit(p, ws, lds, b, 127 - u, qctr, nb, qs + (it & 1), pnl); u = __builtin_amdgcn_readfirstlane(qs[it & 1]); ++it; }
}
DI void pool_phase(const Params& p, int L, const xh_t* xcur, int G, int bid) {
    const int tid = opaque_tid(), lane = tid & 63, wave = __builtin_amdgcn_readfirstlane(tid >> 6);
    unsigned char* ws = opaque_ws(p.ws);
    const float* mod = (const float*)(ws + WS_MOD);
    unsigned* ctl = (unsigned*)(ws + WS_CTL); unsigned* nrc = ctl + CW_NR + (size_t)(L >> 1) * 256 * 64; unsigned* plc = ctl + CW_PL + (size_t)(L >> 1) * 256 * 64;
    for (int u = bid * 2 + (wave >> 2); u < MTOK / 32; u += 2 * G) {
        const int row0 = u * 32, col = ((wave & 3) * 64 + lane) * 4, b = row0 >> 11;
        {
          const int ch = row0 >> 6; const bool prev = ((row0 & 63) == 0) && ((row0 & (SEQ - 1)) != 0);
          unsigned spins = 0;
          while ((unsigned)__builtin_amdgcn_readfirstlane((int)__hip_atomic_load(nrc + 64 * ch, __ATOMIC_RELAXED, __HIP_MEMORY_SCOPE_AGENT)) < 8u ||
                 (prev && (unsigned)__builtin_amdgcn_readfirstlane((int)__hip_atomic_load(nrc + 64 * (ch - 1), __ATOMIC_RELAXED, __HIP_MEMORY_SCOPE_AGENT)) < 8u)) {
              __builtin_amdgcn_s_sleep(2);
              if (++spins > (1u << 20)) { if (lane == 0) __hip_atomic_store(ctl + CW_TMO, 1u, __ATOMIC_RELAXED, __HIP_MEMORY_SCOPE_AGENT); break; } }
          __builtin_amdgcn_fence(__ATOMIC_ACQUIRE, "agent");
          asm volatile("s_waitcnt vmcnt(0)" ::: "memory"); }
        const float* gn = p.norm_mix + (size_t)L * DM; const float* scm = mod + ((size_t)L * 8 + b) * 6144 + 1024;
        const float* rs = (const float*)(ws + WS_RSTD); bf16_t* yo = (bf16_t*)(ws + WS_H);
        switch (wave & 3) {
            case 0: pool_rows<2>(xcur, rs, gn, scm, yo, row0, col); break;
            case 1: pool_rows<4>(xcur, rs, gn, scm, yo, row0, col); break;
            case 2: pool_rows<8>(xcur, rs, gn, scm, yo, row0, col); break;
            default: pool_rows<16>(xcur, rs, gn, scm, yo, row0, col); break;
        }
        asm volatile("s_waitcnt vmcnt(0)" ::: "memory");
        if (lane == 0) (void)__hip_atomic_fetch_add(plc + 64 * (row0 >> 6), 1u, __ATOMIC_RELAXED, __HIP_MEMORY_SCOPE_AGENT);
    }
}
DI void gemm_win(const Params& p, LAS unsigned char* lds, int j2, int cidx, int G, int bid) {
    unsigned char* ws = opaque_ws(p.ws);
    pg8::WinSched S; S.init(64, 9, G, bid); S.A = (const char*)(ws + WS_H); S.B = (const char*)(ws + WS_WIN) + (size_t)j2 * DINP * 1024 * 2;
    S.a_tile = 256 * 2048; S.a_pn = 0; S.b_tile = 256 * 2048; S.lda2 = 2048; S.wpc = (unsigned*)(ws + WS_CTL) + CW_WPC + (size_t)cidx * 64 * 64;
    EpiProj E{(bf16_t*)(ws + WS_PROJ)};
    pg8::gemm_phase<EpiProj, pg8::WinSched, false>(lds, 1024, S, E);
}
DI void win_tail(const Params& p, LAS unsigned char* lds, int j2, int cidx, int G, int bid) {
    const int tid = opaque_tid(), lane = tid & 63, wave = __builtin_amdgcn_readfirstlane(tid >> 6);
    unsigned char* ws = opaque_ws(p.ws);
    { pg8::StaticSched S; S.init(64, 9, G, bid); Unit u;
#pragma unroll 1
      for (int i = 0; S.next(i, u); ++i) if (u.pn == 8) {
#pragma unroll 1
          for (int k = 0; k < 2; ++k) kv_tile(p, ws, j2, u.pm * 16 + wave * 2 + k, lane); } }
    const int nunits = 64 * 9, maxu = (nunits + G - 1) / G, R = nunits - (maxu - 1) * G;
    int rank = bid, n = G;
    if (R < G) { if (bid < R) return; rank = bid - R; n = G - R; }
    unsigned* wpc = (unsigned*)(ws + WS_CTL) + CW_WPC + (size_t)cidx * 64 * 64; unsigned* tmo = (unsigned*)(ws + WS_CTL) + CW_TMO;
#pragma unroll 1
    for (int u = rank; u < 256; u += n) {
        const int pm = u >> 2;
        if (tid < 64) { unsigned spins = 0;
            while ((unsigned)__builtin_amdgcn_readfirstlane((int)__hip_atomic_load(wpc + 64 * pm, __ATOMIC_RELAXED, __HIP_MEMORY_SCOPE_AGENT)) < 32u) {
                __builtin_amdgcn_s_sleep(2);
                if (++spins > (1u << 20)) { if (tid == 0) __hip_atomic_store(tmo, 1u, __ATOMIC_RELAXED, __HIP_MEMORY_SCOPE_AGENT); break; } }
            __builtin_amdgcn_fence(__ATOMIC_ACQUIRE, "agent");
            asm volatile("s_waitcnt vmcnt(0)" ::: "memory"); }
        __syncthreads();
        sgu_unit(p, ws, lds, j2, u);
    }
}
DI void gemm_wo(const Params& p, LAS unsigned char* lds, int L, xh_t* xcur, int G, int bid) {
    unsigned char* ws = opaque_ws(p.ws);
    pg8::WoSched S; S.init(64, 4, G, bid); S.A = (const char*)(ws + WS_CAT); S.B = (const char*)(ws + WS_WO) + (size_t)(L >> 1) * 1024 * 1024 * 2;
    S.a_tile = 256 * 2048; S.a_pn = 0; S.b_tile = 256 * 2048; S.lda2 = 2048; S.pnl = (unsigned*)(ws + WS_CTL) + CW_PNL + (size_t)(L >> 1) * 64 * 64; S.tmo = (unsigned*)(ws + WS_CTL) + CW_TMO; S.xp = (unsigned*)(ws + WS_CTL) + CW_XP + (size_t)L * 64 * 64;
    EpiX E{xcur, (const float*)(ws + WS_MOD) + (size_t)L * 8 * 6144 + 2048, nullptr};
    pg8::gemm_phase<EpiX, pg8::WoSched, false>(lds, 1024, S, E);
}
DI void gemm_pool(const Params& p, LAS unsigned char* lds, int L, xh_t* xcur, int G, int bid) {
    unsigned char* ws = opaque_ws(p.ws);
    pg8::PoolSched S; S.init(64, 4, G, bid); S.A = (const char*)(ws + WS_H); S.B = (const char*)(ws + WS_WPOOL) + (size_t)(L >> 1) * 4 * 256 * 256 * 2;
    S.a_tile = 256 * 2048; S.a_pn = 512; S.b_tile = 256 * 512; S.lda2 = 2048; S.xp = (unsigned*)(ws + WS_CTL) + CW_XP + (size_t)L * 64 * 64;
    S.plc = (unsigned*)(ws + WS_CTL) + CW_PL + (size_t)(L >> 1) * 256 * 64; S.tmo = (unsigned*)(ws + WS_CTL) + CW_TMO;
    EpiX E{xcur, (const float*)(ws + WS_MOD) + (size_t)L * 8 * 6144 + 2048, p.pool_scale + (size_t)(L >> 1) * DM};
    pg8::gemm_phase<EpiX, pg8::PoolSched, false>(lds, 256, S, E);
}
template <bool HALVES>
DI void gemm_gu(const Params& p, LAS unsigned char* lds, int L, const LAS int* toff, const LAS int* cntl, int T, int G, int bid) {
    unsigned char* ws = opaque_ws(p.ws);
    MoeGUSched S{toff, cntl, T, G, bid, HALVES ? 1 : 0, (const int*)(ws + WS_TOKIDX), (const char*)(ws + WS_H), (const char*)(ws + WS_WGU) + (size_t)L * 32 * 512 * 1024 * 2,
                 (unsigned*)(ws + WS_CTL) + CW_MTC + (size_t)L * 160 * 64};
    EpiGU<HALVES> E{(bf16_t*)(ws + WS_ACT), (const float*)(ws + WS_GATES)};
    pg8::gemm_phase<EpiGU<HALVES>, MoeGUSched, true>(lds, 1024, S, E);
}
DI void gemm_down(const Params& p, LAS unsigned char* lds, int L, const LAS int* toff, const LAS int* cntl, int T, int G, int bid) {
    unsigned char* ws = opaque_ws(p.ws);
    MoeDownSched S{toff, T, G, bid, (const char*)(ws + WS_ACT), (const char*)(ws + WS_WDN) + (size_t)L * 32 * 1024 * 256 * 2,
                   (unsigned*)(ws + WS_CTL) + CW_MTC + (size_t)L * 160 * 64, (unsigned*)(ws + WS_CTL) + CW_TMO};
    EpiDown E{(bf16_t*)(ws + WS_YMOE), toff, cntl};
    pg8::gemm_phase<EpiDown, MoeDownSched, false>(lds, 256, S, E);
}

#define BARX() do { xcd_barrier(bar); if (PROBE_MASK & (1 << 15)) xcd_barrier(bar); } while (0)
#define RUN(bit, stmt) do { stmt; if (PROBE_MASK & (1 << (bit))) { xcd_barrier(bar); stmt; } } while (0)
__global__ void __launch_bounds__(512, 2) mk_fwd(Params p) {
    extern __shared__ __attribute__((aligned(16))) unsigned char lds_raw[];
    LAS unsigned char* lds = (LAS unsigned char*)lds_raw;
    const int G = gridDim.x, bid = blockIdx.x;
    unsigned* ctl = (unsigned*)(p.ws + WS_CTL);
    volatile LAS unsigned* MISC = (volatile LAS unsigned*)(lds + MISC_OFF);
    if (threadIdx.x < 64) MISC[threadIdx.x] = 0u;
    __syncthreads();
    XcdBarrier bar = xcd_barrier_post(ctl + CW_BAR, MISC + 8);
    LAS int* toff = (LAS int*)(lds + TAB_OFF); LAS int* cntl = (LAS int*)(lds + TAB_OFF + 256);
    xh_t* xb0 = (xh_t*)(p.ws + WS_X0); xh_t* xb1 = (xh_t*)(p.ws + WS_X1);

    RUN(0, p0_prologue(p, lds, G, bid));
    BARX();

#pragma unroll 1
    for (int L = 0; L < 4; ++L) {
        const float* xin32 = (L == 0) ? p.x : nullptr;
        const xh_t* xin = (L & 1) ? xb0 : xb1;
        xh_t* xcur = (L & 1) ? xb1 : xb0;
        if ((L & 1) == 0) {
            RUN(1, norm_rows<0>(p, L, xin32, xin, xcur, L > 0, toff, G, bid));
            BARX();
            if (PROBE_MASK & (1 << 2)) { gemm_win(p, lds, L >> 1, 2 + (L >> 1), G, bid); xcd_barrier(bar); }
            gemm_win(p, lds, L >> 1, L >> 1, G, bid);
            win_tail(p, lds, L >> 1, L >> 1, G, bid);
            BARX();
            a45_phase(p, lds, G, bid, L >> 1);
            gemm_wo(p, lds, L, xcur, G, bid);
        } else {
            norm_rows<1>(p, L, nullptr, xin, xcur, true, toff, G, bid, ctl + CW_NR + (size_t)(L >> 1) * 256 * 64);
            pool_phase(p, L, xcur, G, bid);
            gemm_pool(p, lds, L, xcur, G, bid);
        }
        norm2_phase(p, lds, L, L, xcur, G, bid);
        BARX();
        const int T = moe_tables(ctl, L, toff, cntl, opaque_tid());
        gemm_gu<false>(p, lds, L, toff, cntl, T, G, bid);
        gemm_gu<true>(p, lds, L, toff, cntl, T, G, bid);
        RUN(8, gemm_down(p, lds, L, toff, cntl, T, G, bid));
        BARX();
    }
    RUN(11, norm_rows<3>(p, 4, nullptr, xb1, nullptr, true, toff, G, bid));
}

extern "C" void kernel_launch(void* const* d_in, const int* in_sizes, int n_in, void* d_out, int out_size, void* d_ws, size_t ws_size, hipStream_t stream) {
    static int grid = 0;
    if (grid == 0) {
        if (n_in != 23 || out_size != MTOK * DM || ws_size < WS_END) { fprintf(stderr, "kernel_launch: unexpected shapes (n_in %d out %d ws %zu need %zu)\n", n_in, out_size, ws_size, (size_t)WS_END); grid = -1; return; }
        int dev = 0, cus = 0, per_cu = 0;
        if (hipGetDevice(&dev) != hipSuccess || hipDeviceGetAttribute(&cus, hipDeviceAttributeMultiprocessorCount, dev) != hipSuccess) { grid = -1; return; }
        if (hipFuncSetAttribute((const void*)mk_fwd, hipFuncAttributeMaxDynamicSharedMemorySize, LDS_BYTES) != hipSuccess) { fprintf(stderr, "kernel_launch: hipFuncSetAttribute failed\n"); grid = -1; return; }
        if (hipOccupancyMaxActiveBlocksPerMultiprocessor(&per_cu, (const void*)mk_fwd, 512, LDS_BYTES) != hipSuccess || per_cu < 1)
            fprintf(stderr, "kernel_launch: occupancy query reports %d\n", per_cu);
        (void)hipGetLastError();
        grid = cus < 256 ? cus : 256;
    }
    if (grid < 0) return;
    (void)hipMemsetAsync((char*)d_ws + WS_CTL, 0, CTL_BYTES, stream);
    Params p{};
    const float** f = (const float**)&p;
    for (int i = 0; i < 23; ++i) f[i] = (const float*)d_in[i];
    p.out = (float*)d_out; p.ws = (unsigned char*)d_ws;
    hipLaunchKernelGGL(mk_fwd, dim3(grid), dim3(512), LDS_BYTES, stream, p);
}
```

```cpp
#include <hip/hip_runtime.h>
#include <cstdio>
#include <cstdint>

#define LAS __attribute__((address_space(3)))
#define DI __device__ __forceinline__
typedef unsigned short bf16_t;
typedef short bf16x8 __attribute__((ext_vector_type(8)));
typedef float f32x4 __attribute__((ext_vector_type(4)));
typedef float f32x2 __attribute__((ext_vector_type(2)));
typedef unsigned u32x4 __attribute__((ext_vector_type(4)));
typedef unsigned u32x2 __attribute__((ext_vector_type(2)));
typedef short s16x4 __attribute__((ext_vector_type(4)));
typedef __bf16 bfv2 __attribute__((ext_vector_type(2)));
typedef _Float16 h16x4 __attribute__((ext_vector_type(4)));
typedef _Float16 h16x8 __attribute__((ext_vector_type(8)));
typedef _Float16 xh_t;

constexpr int NB = 8, SEQ = 2048, DM = 1024, MTOK = NB * SEQ;
constexpr int DIN = 2248, DINP = 2304;
constexpr int PC_Q = 0, PC_QI = 512, PC_U = 1024, PC_V = 1536, PC_KVL = 2048, PC_KI = 2176, PC_WI = 2240;
constexpr int NEXP = 32, CAP = 16384, MAXPOS = 40960;
constexpr float EPS = 1e-6f;
constexpr float LOG2E = 1.4426950408889634f;

constexpr size_t MiB = 1u << 20;
constexpr size_t WS_CTL = 0, CTL_BYTES = 704 * 1024;
constexpr size_t WS_MOD = 1 * MiB;
constexpr size_t WS_WR = 2 * MiB;
constexpr size_t WS_WKV = 3 * MiB;
constexpr size_t WS_WS = 4 * MiB;
constexpr size_t WS_WPOOL = 5 * MiB;
constexpr size_t WS_WIN = 6 * MiB;
constexpr size_t WS_WO = 15 * MiB;
constexpr size_t WS_TOKMETA = 19 * MiB;
constexpr size_t WS_RSTD = 19 * MiB + 256 * 1024;
constexpr size_t WS_TOKIDX = 20 * MiB;
constexpr size_t WS_GATES = 22 * MiB;
constexpr size_t WS_K = 24 * MiB;
constexpr size_t WS_VT = 26 * MiB;
constexpr size_t WS_WGU = 28 * MiB;
constexpr size_t WS_WDN = 156 * MiB;
constexpr size_t WS_X0 = 220 * MiB, WS_X1 = 284 * MiB;
constexpr size_t WS_H = 348 * MiB;
constexpr size_t WS_PROJ = 380 * MiB;
constexpr size_t WS_CAT = 452 * MiB;
constexpr size_t WS_YBUF = 380 * MiB;
constexpr size_t WS_ACT = 380 * MiB;
constexpr size_t WS_YMOE = 400 * MiB;
constexpr size_t WS_END = 484 * MiB;
constexpr int CW_BAR = 4096;
constexpr int CW_CNT = 8192;
constexpr int CW_TMO = 64;
constexpr int CW_MTC = 16384;
constexpr int CW_WPC = 61440;
constexpr int CW_A45Q = 80000;
constexpr int CW_PNL = 84000;
constexpr int CW_XP = 92192;
constexpr int CW_NR = 108576;
constexpr int CW_PL = 141344;
constexpr int CW_CVQ = 12288;

constexpr int STAGE_REGION = 131072;
constexpr int SC_PITCH = 2052;
constexpr int IDX_OFF = 16 * SC_PITCH * 4;
constexpr int MISC_OFF = 139776;
constexpr int TAB_OFF = MISC_OFF + 256;
constexpr int KSTG_OFF = 143360;
constexpr int QSLOT_OFF = KSTG_OFF + 8 * 2048;
constexpr int LDS_BYTES = 163840;

#ifndef PROBE_MASK
#define PROBE_MASK 0
#endif
#define LDS_WAIT() asm volatile("s_waitcnt lgkmcnt(0)" ::: "memory")
DI int opaque_tid() { int t = threadIdx.x; asm volatile("" : "+v"(t)); return t; }
DI unsigned char* opaque_ws(unsigned char* p) { size_t z = 0; asm volatile("" : "+s"(z)); return p + z; }

DI unsigned pk2(float a, float b) { f32x2 v = {a, b}; bfv2 r = __builtin_convertvector(v, bfv2); return __builtin_bit_cast(unsigned, r); }
DI f32x4 ldx4(const xh_t* p) { return __builtin_convertvector(*(const h16x4*)p, f32x4); }
DI void stx4(xh_t* p, f32x4 v) { *(h16x4*)p = __builtin_convertvector(v, h16x4); }
DI float bflo(unsigned u) { return __uint_as_float(u << 16); }
DI float bfhi(unsigned u) { return __uint_as_float(u & 0xffff0000u); }
DI float shx(float v, int o, int lane) { return __int_as_float(__builtin_amdgcn_ds_bpermute((lane ^ o) << 2, __float_as_int(v))); }
DI float wave_sum(float v, int lane) {
#pragma unroll
    for (int o = 1; o < 64; o <<= 1) v += shx(v, o, lane);
    return v;
}
DI float gelu_tanh(float x) {
    const float t = x * x;
    const float inner = x * (0.7978845608f + 0.0356774081f * t);
    const float e = __builtin_amdgcn_exp2f(-2.8853900818f * inner);
    return x * __builtin_amdgcn_rcpf(1.0f + e);
}
DI float silu_f(float x) { return x * __builtin_amdgcn_rcpf(1.0f + __builtin_amdgcn_exp2f(-LOG2E * x)); }

#define XB_TMO      128
#define XB_XCNT(j)  (256  + 64 * (j))
#define XB_XSUB(j)  (1280 + 64 * (j))
#define XB_XGEN(j)  (2304 + 64 * (j))
#define XB_TOP      3328
#define XB_TOPGEN   3392
#define XCD_BAR_WORDS 3456
#define XB_SPIN_CAP (1u << 18)

__device__ __forceinline__ unsigned xb_ld(unsigned* p)              { return __hip_atomic_load(p, __ATOMIC_RELAXED, __HIP_MEMORY_SCOPE_AGENT); }
__device__ __forceinline__ unsigned xb_add(unsigned* p, unsigned v) { return __hip_atomic_fetch_add(p, v, __ATOMIC_RELAXED, __HIP_MEMORY_SCOPE_AGENT); }
__device__ __forceinline__ unsigned xb_xcc_id() { return (unsigned)__builtin_amdgcn_s_getreg((3 << 11) | 20) & 0xFu; }
#define XB_SPIN(cond, bar) do { unsigned _sp = 0; while (cond) { __builtin_amdgcn_s_sleep(1); \
    if ((++_sp & 255u) == 0u) { if (xb_ld(&(bar)[XB_TMO])) break; if (_sp > XB_SPIN_CAP) { atomicAdd(&(bar)[XB_TMO], 1u); break; } } } } while (0)

struct XcdBarrier {
    unsigned* bar; unsigned x;
    volatile LAS unsigned* st;
};
__device__ __forceinline__ XcdBarrier xcd_barrier_post(unsigned* bar, volatile LAS unsigned* st) {
    XcdBarrier b; b.bar = bar; b.x = xb_xcc_id(); b.st = st;
    if (threadIdx.x == 0) (void)xb_add(&bar[XB_XCNT(b.x)], 1u);
    return b;
}
__device__ __forceinline__ void xcd_barrier_complete(unsigned* bar, unsigned x, unsigned& nloc, unsigned& nx) {
    const unsigned G = gridDim.x * gridDim.y * gridDim.z;
    unsigned sum, cnt, mine, sp = 0u;
    for (;;) {
        sum = 0u; cnt = 0u; mine = 0u;
#pragma unroll
        for (unsigned j = 0; j < 16; ++j) { const unsigned c = xb_ld(&bar[XB_XCNT(j)]); sum += c; cnt += (c > 0u) ? 1u : 0u; mine = (j == x) ? c : mine; }
        if (sum == G) break;
        __builtin_amdgcn_s_sleep(1);
        if ((++sp & 255u) == 0u) { if (xb_ld(&bar[XB_TMO])) break; if (sp > XB_SPIN_CAP) { atomicAdd(&bar[XB_TMO], 1u); break; } }
    }
    nloc = mine > 0u ? mine : 1u; nx = cnt > 0u ? cnt : 1u;
}
__device__ __forceinline__ void xcd_barrier(const XcdBarrier& b) {
    asm volatile("s_waitcnt vmcnt(0)" ::: "memory");
    __syncthreads();
    if (threadIdx.x == 0) {
        size_t bz = 0; unsigned bx = b.x;
        asm volatile("" : "+s"(bz), "+s"(bx)); unsigned* bar = b.bar + bz;
        __builtin_amdgcn_s_waitcnt(0);
        unsigned nloc = b.st[0], nx = b.st[1];
        if (nloc == 0u) { xcd_barrier_complete(bar, bx, nloc, nx); b.st[0] = nloc; b.st[1] = nx; }
        const unsigned old = xb_add(&bar[XB_XSUB(bx)], 1u);
        const unsigned gen = old / nloc;
        if (old + 1u == (gen + 1u) * nloc) {
            __builtin_amdgcn_fence(__ATOMIC_RELEASE, "agent");
            asm volatile("s_waitcnt vmcnt(0)" ::: "memory");
            const unsigned og = xb_add(&bar[XB_TOP], 1u);
            const unsigned tg = og / nx;
            if (og + 1u == (tg + 1u) * nx) { xb_add(&bar[XB_TOPGEN], 1u); xb_add(&bar[XB_XGEN(bx)], 1u); __builtin_amdgcn_fence(__ATOMIC_ACQUIRE, "agent"); }
            else { __builtin_amdgcn_fence(__ATOMIC_ACQUIRE, "agent"); XB_SPIN(xb_ld(&bar[XB_TOPGEN]) == tg, bar); xb_add(&bar[XB_XGEN(bx)], 1u); }
            asm volatile("s_waitcnt vmcnt(0)" ::: "memory");
        } else {
            __builtin_amdgcn_fence(__ATOMIC_ACQUIRE, "agent");
            XB_SPIN(xb_ld(&bar[XB_XGEN(bx)]) == gen, bar);
            asm volatile("s_waitcnt vmcnt(0)" ::: "memory");
        }
    }
    __syncthreads();
}

namespace pg8 {
constexpr int BM = 256, BK = 64, HALF = 128, HTB = HALF * BK * 2, NXCD = 8, WGM = 8;
DI int lds_byte(int r, int c) { const int st = (r >> 4) * 2 + (c >> 5), rr = r & 15, cc = c & 31, ob = rr * 64 + cc * 2; return st * 1024 + (ob ^ (((ob >> 9) & 1) << 5)); }
DI void stage_rc(int b, int& R, int& C) { const int st = b / 1024, sb = b % 1024, swz = sb ^ (((sb >> 9) & 1) << 5); R = (st >> 1) * 16 + swz / 64; C = (st & 1) * 32 + (swz % 64) / 2; }
DI int perm32(int rho) { const int n = rho >> 4, i = rho & 15; return 8 * (i >> 2) + 4 * n + (i & 3); }

struct Unit { int pm, pn, aux; };

struct StaticSched {
    int nM, nN, nwg, G, c;
    const char* A; const char* B; size_t a_tile, a_pn, b_tile; unsigned lda2;
    DI void init(int nM_, int nN_, int G_, int c_) { nM = nM_; nN = nN_; nwg = nM * nN; G = G_; c = c_; }
    DI bool next(int i, Unit& u) const {
        const long L = (long)i * G + c; if (L >= nwg) return false;
        int wgid = (int)L; { const int q = nwg / NXCD, r = nwg % NXCD, xcd = wgid % NXCD, off = wgid / NXCD; wgid = (xcd < r ? xcd * (q + 1) : r * (q + 1) + (xcd - r) * q) + off; }
        const int nig = WGM * nN, gid = wgid / nig, fm = gid * WGM, gsz = (nM - fm) < WGM ? (nM - fm) : WGM;
        u.pm = fm + ((wgid % nig) % gsz); u.pn = (wgid % nig) / gsz; u.aux = 0; return true;
    }
    DI const char* a_ptr(const Unit& u) const { return A + (size_t)u.pm * a_tile + (size_t)u.pn * a_pn; }
    DI const char* b_ptr(const Unit& u) const { return B + (size_t)u.pn * b_tile; }
    DI unsigned a_rowoff(const Unit&, int r) const { return (unsigned)r * lda2; }
    DI void a_ready(const Unit&, int, unsigned) const {}
    DI unsigned early(const Unit&, int) const { return 0u; }
    DI void done(const Unit&, int) const {}
};

struct WinSched : StaticSched {
    unsigned* wpc;
    DI void done(const Unit& u, int tid) const {
        if (u.pn >= 4 && u.pn < 8) { asm volatile("s_waitcnt vmcnt(0)" ::: "memory");
            if ((tid & 63) == 0) (void)__hip_atomic_fetch_add(wpc + 64 * u.pm, 1u, __ATOMIC_RELAXED, __HIP_MEMORY_SCOPE_AGENT); }
    }
};
struct XpSched : StaticSched {
    unsigned* xp;
    DI void done(const Unit& u, int tid) const {
        asm volatile("s_waitcnt vmcnt(0)" ::: "memory");
        if ((tid & 63) == 0) (void)__hip_atomic_fetch_add(xp + 64 * u.pm, 1u, __ATOMIC_RELAXED, __HIP_MEMORY_SCOPE_AGENT); }
};
struct PoolSched : XpSched {
    unsigned* plc; unsigned* tmo;
    DI void a_ready(const Unit& u, int tid, unsigned) const {
        if (tid < 64) { const int ch = 4 * u.pm + (tid & 7); const bool need = (tid < 4) || (tid == 4 && ch < MTOK / 64 && (ch & 31) != 0);
            unsigned spins = 0;
            for (;;) { const unsigned v = need ? __hip_atomic_load(plc + 64 * ch, __ATOMIC_RELAXED, __HIP_MEMORY_SCOPE_AGENT) : 8u;
                if (__ballot(v < 8u) == 0ull) break;
                __builtin_amdgcn_s_sleep(2);
                if (++spins > (1u << 20)) { if (tid == 0) __hip_atomic_store(tmo, 1u, __ATOMIC_RELAXED, __HIP_MEMORY_SCOPE_AGENT); break; } }
            __builtin_amdgcn_fence(__ATOMIC_ACQUIRE, "agent");
            asm volatile("s_waitcnt vmcnt(0)" ::: "memory"); }
        asm volatile("" ::: "memory"); __builtin_amdgcn_s_barrier(); asm volatile("" ::: "memory");
    }
};
struct WoSched : XpSched {
    unsigned* pnl; unsigned* tmo;
    DI void a_ready(const Unit& u, int tid, unsigned) const {
        if (tid < 64) { unsigned spins = 0;
            while ((unsigned)__builtin_amdgcn_readfirstlane((int)__hip_atomic_load(pnl + 64 * u.pm, __ATOMIC_RELAXED, __HIP_MEMORY_SCOPE_AGENT)) < 16u) {
                __builtin_amdgcn_s_sleep(2);
                if (++spins > (1u << 20)) { if (tid == 0) __hip_atomic_store(tmo, 1u, __ATOMIC_RELAXED, __HIP_MEMORY_SCOPE_AGENT); break; } }
            __builtin_amdgcn_fence(__ATOMIC_ACQUIRE, "agent");
            asm volatile("s_waitcnt vmcnt(0)" ::: "memory"); }
        asm volatile("" ::: "memory"); __builtin_amdgcn_s_barrier(); asm volatile("" ::: "memory");
    }
};
#define PG8_SA(b, h) (((b) * 2 + (h)) * HTB)
#define PG8_SB(b, h) ((4 + (b) * 2 + (h)) * HTB)
#define PG8_STAGE(bufoff, gbase, voff) do { _Pragma("unroll") for (int _i = 0; _i < 2; ++_i) \
        __builtin_amdgcn_global_load_lds((const unsigned*)((const char*)(gbase) + (voff)[_i]), (LAS unsigned*)(lds + (bufoff) + ldsw + _i * 8192), 16, 0, 0); } while (0)
#define PG8_LDA(dst, b, h) do { _Pragma("unroll") for (int m = 0; m < 4; ++m) _Pragma("unroll") for (int k = 0; k < 2; ++k) dst[m][k] = *(const LAS bf16x8*)(lds + PG8_SA(b, h) + aoff + m * 2048 + k * 1024); } while (0)
#define PG8_LDB(dst, b, h) do { _Pragma("unroll") for (int n = 0; n < 2; ++n) _Pragma("unroll") for (int k = 0; k < 2; ++k) dst[n][k] = *(const LAS bf16x8*)(lds + PG8_SB(b, h) + boff + n * 2048 + k * 1024); } while (0)
#define PG8_MMA(ai, bj, At, Bt) do { __builtin_amdgcn_s_setprio(1); _Pragma("unroll") for (int m = 0; m < 4; ++m) _Pragma("unroll") for (int n = 0; n < 2; ++n) _Pragma("unroll") for (int k = 0; k < 2; ++k) \
        acc[ai][bj][m][n] = __builtin_amdgcn_mfma_f32_16x16x32_bf16(Bt[n][k], At[m][k], acc[ai][bj][m][n], 0, 0, 0); __builtin_amdgcn_s_setprio(0); } while (0)
#define PG8_WAIT_V(n) asm volatile("s_waitcnt vmcnt(" #n ")" ::: "memory")
#define PG8_WAIT_L(n) asm volatile("s_waitcnt lgkmcnt(" #n ")" ::: "memory")
#define PG8_BAR __builtin_amdgcn_s_barrier()
#define PG8_SCHED __builtin_amdgcn_sched_barrier(0)

template <class Epi, class Sched, bool GATHER>
DI void gemm_phase(LAS unsigned char* lds, const int K_, const Sched& S, const Epi& E) {
    int K = K_; asm volatile("" : "+s"(K));
    const int tid = opaque_tid(), wid = __builtin_amdgcn_readfirstlane(tid >> 6), lane = tid & 63, wr = wid >> 2, wc = wid & 3, fr = lane & 15, fq = lane >> 4;
    constexpr bool THIN = Epi::THIN;
#define PG8_WAIT_VK() do { if (THIN) PG8_WAIT_V(6); else PG8_WAIT_V(8); } while (0)
    const int nt = K / BK;
    unsigned voffB[2];
#pragma unroll
    for (int i = 0; i < 2; ++i) { int R, C; stage_rc(tid * 16 + i * 8192, R, C); const int Rb = Epi::PERM ? ((R & ~31) + perm32(R & 31)) : R;
        voffB[i] = (unsigned)(Rb * K + C) * 2u; }
    const size_t kstep = (size_t)(BK * 2);
    const size_t hstepB = (size_t)HALF * K * 2;
    const unsigned ldsw = (unsigned)wid * 1024u;
    const int aoff = lds_byte(wr * 64 + fr, fq * 8), boff = lds_byte(wc * 32 + fr, fq * 8);
    Unit cur, nxt; int ui = 0;
    if (!S.next(0, cur)) return;
    unsigned voffA[GATHER ? 2 : 1][2]; unsigned hstepA = 0;
#define PG8_SETA(UU) do { _Pragma("unroll") for (int _i = 0; _i < 2; ++_i) { int R, C; stage_rc(tid * 16 + _i * 8192, R, C); \
        voffA[0][_i] = S.a_rowoff(UU, R) + (unsigned)(C * 2); if (GATHER) voffA[GATHER ? 1 : 0][_i] = S.a_rowoff(UU, HALF + R) + (unsigned)(C * 2); } } while (0)
    PG8_SETA(cur);
    if (!GATHER) hstepA = S.a_rowoff(cur, HALF);
#define VA0 voffA[0]
#define VA1 voffA[GATHER ? 1 : 0]
    f32x4 acc[2][2][4][2];
#pragma unroll
    for (int a = 0; a < 2; ++a)
#pragma unroll
        for (int b = 0; b < 2; ++b)
#pragma unroll
            for (int m = 0; m < 4; ++m)
#pragma unroll
                for (int n = 0; n < 2; ++n) acc[a][b][m][n] = (f32x4){0.f, 0.f, 0.f, 0.f};
    bf16x8 At[4][2], B0[2][2], B1[2][2];
    const char* cA = S.a_ptr(cur); const char* cB = S.b_ptr(cur);
    S.a_ready(cur, tid, 0u);
    PG8_STAGE(PG8_SB(0, 0), cB, voffB); PG8_STAGE(PG8_SB(0, 1), cB + hstepB, voffB); PG8_STAGE(PG8_SA(0, 0), cA, VA0); if (!THIN) PG8_STAGE(PG8_SA(0, 1), cA + hstepA, VA1);
    if (wr == 1) PG8_BAR;
    if (THIN) PG8_WAIT_V(0); else PG8_WAIT_V(2);
    PG8_BAR;
    PG8_STAGE(PG8_SB(1, 0), cB + kstep, voffB); PG8_STAGE(PG8_SA(1, 0), cA + kstep, VA0); PG8_STAGE(PG8_SB(1, 1), cB + hstepB + kstep, voffB);
    PG8_WAIT_V(6); PG8_BAR;
    for (;;) {
        const bool has_next = S.next(ui + 1, nxt);
        const unsigned erd = has_next ? S.early(nxt, tid) : 0u;
        const char* nA = has_next ? S.a_ptr(nxt) : cA; const char* nB = has_next ? S.b_ptr(nxt) : cB;
        for (int t = 0; t < nt; t += 2) {
            const bool last = (t == nt - 2);
            const char* a1 = cA + (size_t)(t + 1) * kstep;
            const char* a2 = last ? nA : cA + (size_t)(t + 2) * kstep; const char* b2 = last ? nB : cB + (size_t)(t + 2) * kstep;
            const char* a3 = a2 + kstep; const char* b3 = b2 + kstep;
            const bool sw = GATHER && last && has_next;
            if (last && has_next) S.a_ready(nxt, tid, erd);
            PG8_LDB(B0, 0, 0); PG8_LDB(B1, 0, 1); PG8_SCHED; PG8_LDA(At, 0, 0); if (!THIN) PG8_STAGE(PG8_SA(1, 1), a1 + hstepA, VA1);
            PG8_WAIT_VK(); PG8_WAIT_L(0); PG8_BAR; PG8_MMA(0, 0, At, B0); PG8_MMA(0, 1, At, B1); PG8_BAR; PG8_SCHED;
            if (sw) PG8_SETA(nxt);
            if (!THIN) PG8_LDA(At, 0, 1); PG8_STAGE(PG8_SB(0, 0), b2, voffB); PG8_STAGE(PG8_SB(0, 1), b2 + hstepB, voffB); PG8_STAGE(PG8_SA(0, 0), a2, VA0);
            PG8_WAIT_VK(); PG8_WAIT_L(0); PG8_BAR; if (!THIN) { PG8_MMA(1, 0, At, B0); PG8_MMA(1, 1, At, B1); } PG8_BAR; PG8_SCHED;
            PG8_LDB(B0, 1, 0); PG8_LDB(B1, 1, 1); PG8_SCHED; PG8_LDA(At, 1, 0); if (!THIN) PG8_STAGE(PG8_SA(0, 1), a2 + hstepA, VA1);
            PG8_WAIT_VK(); PG8_WAIT_L(0); PG8_BAR; PG8_MMA(0, 0, At, B0); PG8_MMA(0, 1, At, B1); PG8_BAR; PG8_SCHED;
            if (!THIN) PG8_LDA(At, 1, 1); PG8_STAGE(PG8_SB(1, 0), b3, voffB); PG8_STAGE(PG8_SB(1, 1), b3 + hstepB, voffB); PG8_STAGE(PG8_SA(1, 0), a3, VA0);
            PG8_WAIT_VK(); PG8_WAIT_L(0); PG8_BAR; if (!THIN) { PG8_MMA(1, 0, At, B0); PG8_MMA(1, 1, At, B1); } PG8_BAR; PG8_SCHED;
        }
        if (wr == 0) PG8_BAR;
        E(acc, cur, wr, wc, fr, fq);
        S.done(cur, tid);
        if (!has_next) break;
#pragma unroll
        for (int a = 0; a < 2; ++a)
#pragma unroll
            for (int b = 0; b < 2; ++b)
#pragma unroll
                for (int m = 0; m < 4; ++m)
#pragma unroll
                    for (int n = 0; n < 2; ++n) acc[a][b][m][n] = (f32x4){0.f, 0.f, 0.f, 0.f};
        cur = nxt; cA = nA; cB = nB; ++ui;
        if (wr == 1) PG8_BAR;
    }
    PG8_WAIT_V(0);
    PG8_BAR;
#undef PG8_SETA
#undef VA0
#undef VA1
}
}
using pg8::Unit;

struct Params {
    const float *x, *c, *w_mod, *b_mod, *norm_mix, *norm_ffn, *w_in, *kv_norm, *w_kv_up, *sgu_norm, *w_s, *b_s, *w_o, *w_pool, *pool_scale,
                *w_gr, *b_gr, *w_er, *b_er, *w_gate, *w_up, *w_down, *norm_out;
    float* out; unsigned char* ws;
};

struct EpiProj {
    static constexpr bool PERM = true, THIN = false;
    bf16_t* O;
    DI void operator()(const f32x4 (&acc)[2][2][4][2], const Unit& u, int wr, int wc, int fr, int fq) const {
        const int row0 = u.pm * 256 + wr * 64 + fr, col0 = u.pn * 256 + wc * 32 + 8 * fq;
        const bool act = (u.pn >= 4 && u.pn < 8);
        const __amdgpu_buffer_rsrc_t rs = __builtin_amdgcn_make_buffer_rsrc(O, 0, 0x7fffffff, 0x00020000);
#pragma unroll
        for (int ai = 0; ai < 2; ++ai)
#pragma unroll
            for (int m = 0; m < 4; ++m) { bf16_t* rowp = O + (size_t)(row0 + ai * 128 + m * 16) * DINP + col0;
#pragma unroll
                for (int bj = 0; bj < 2; ++bj) { f32x4 v0 = acc[ai][bj][m][0], v1 = acc[ai][bj][m][1];
                    if (act) {
#pragma unroll
                        for (int j = 0; j < 4; ++j) { v0[j] = gelu_tanh(v0[j]); v1[j] = gelu_tanh(v1[j]); } }
                    u32x4 w; w.x = pk2(v0[0], v0[1]); w.y = pk2(v0[2], v0[3]); w.z = pk2(v1[0], v1[1]); w.w = pk2(v1[2], v1[3]);
                    if (act) __builtin_amdgcn_raw_buffer_store_b128(w, rs, (int)(((unsigned)(row0 + ai * 128 + m * 16) * (unsigned)DINP + (unsigned)(col0 + bj * 128)) * 2u), 0, 16);
                    else *(u32x4*)(rowp + bj * 128) = w; } }
    }
};
struct EpiY {
    static constexpr bool PERM = true, THIN = false;
    bf16_t* Y; const float* gm; const float* scale;
    DI void operator()(const f32x4 (&acc)[2][2][4][2], const Unit& u, int wr, int wc, int fr, int fq) const {
        const int row0 = u.pm * 256 + wr * 64 + fr, col0 = u.pn * 256 + wc * 32 + 8 * fq, b = u.pm >> 3;
        f32x4 gv[2][2];
#pragma unroll
        for (int bj = 0; bj < 2; ++bj)
#pragma unroll
            for (int n = 0; n < 2; ++n) { gv[bj][n] = *(const f32x4*)(gm + (size_t)b * 6144 + col0 + bj * 128 + n * 4);
                if (scale) gv[bj][n] *= *(const f32x4*)(scale + col0 + bj * 128 + n * 4); }
#pragma unroll
        for (int ai = 0; ai < 2; ++ai)
#pragma unroll
            for (int m = 0; m < 4; ++m) { bf16_t* rowp = Y + (size_t)(row0 + ai * 128 + m * 16) * DM + col0;
#pragma unroll
                for (int bj = 0; bj < 2; ++bj) { const f32x4 v0 = acc[ai][bj][m][0] * gv[bj][0], v1 = acc[ai][bj][m][1] * gv[bj][1];
                    u32x4 w; w.x = pk2(v0[0], v0[1]); w.y = pk2(v0[2], v0[3]); w.z = pk2(v1[0], v1[1]); w.w = pk2(v1[2], v1[3]);
                    *(u32x4*)(rowp + bj * 128) = w; } }
    }
};
struct EpiX {
    static constexpr bool PERM = true, THIN = false;
    xh_t* X; const float* gm; const float* scale;
    DI void operator()(const f32x4 (&acc)[2][2][4][2], const Unit& u, int wr, int wc, int fr, int fq) const {
        const int row0 = u.pm * 256 + wr * 64 + fr, col0 = u.pn * 256 + wc * 32 + 8 * fq, b = u.pm >> 3;
        const __amdgpu_buffer_rsrc_t xrs = __builtin_amdgcn_make_buffer_rsrc(X, 0, 0x7fffffff, 0x00020000);
        u32x4 xr[2][4][2];
#pragma unroll
        for (int ai = 0; ai < 2; ++ai)
#pragma unroll
            for (int m = 0; m < 4; ++m)
#pragma unroll
                for (int bj = 0; bj < 2; ++bj) xr[ai][m][bj] = *(const u32x4*)(X + (size_t)(row0 + ai * 128 + m * 16) * DM + col0 + bj * 128);
        f32x4 gv[2][2];
#pragma unroll
        for (int bj = 0; bj < 2; ++bj)
#pragma unroll
            for (int n = 0; n < 2; ++n) { gv[bj][n] = *(const f32x4*)(gm + (size_t)b * 6144 + col0 + bj * 128 + n * 4);
                if (scale) gv[bj][n] *= *(const f32x4*)(scale + col0 + bj * 128 + n * 4); }
#pragma unroll
        for (int ai = 0; ai < 2; ++ai)
#pragma unroll
            for (int m = 0; m < 4; ++m) { const unsigned rowb = ((unsigned)(row0 + ai * 128 + m * 16) * (unsigned)DM + (unsigned)col0) * 2u;
#pragma unroll
                for (int bj = 0; bj < 2; ++bj) { const f32x4 v0 = acc[ai][bj][m][0] * gv[bj][0], v1 = acc[ai][bj][m][1] * gv[bj][1];
                    const u32x4 xw = xr[ai][m][bj];
                    const h16x4 x0 = __builtin_bit_cast(h16x4, (u32x2){xw.x, xw.y}), x1 = __builtin_bit_cast(h16x4, (u32x2){xw.z, xw.w});
                    const h16x4 o0 = __builtin_convertvector(__builtin_convertvector(x0, f32x4) + v0, h16x4), o1 = __builtin_convertvector(__builtin_convertvector(x1, f32x4) + v1, h16x4);
                    const u32x2 p0 = __builtin_bit_cast(u32x2, o0), p1 = __builtin_bit_cast(u32x2, o1);
                    __builtin_amdgcn_raw_buffer_store_b128((u32x4){p0.x, p0.y, p1.x, p1.y}, xrs, (int)(rowb + bj * 256u), 0, 16); } }
    }
};
template <bool THIN_>
struct EpiGU {
    static constexpr bool PERM = true, THIN = THIN_;
    bf16_t* act; const float* gates;
    DI void operator()(const f32x4 (&acc)[2][2][4][2], const Unit& u, int wr, int wc, int fr, int fq) const {
        const int e = u.aux & 0xff, ml = (u.aux >> 8) & 0xff, hs = (u.aux >> 16) & 1;
        const int f0 = u.pn * 128 + wc * 32 + 8 * fq;
        const __amdgpu_buffer_rsrc_t rs = __builtin_amdgcn_make_buffer_rsrc(act, 0, 0x7fffffff, 0x00020000);
#pragma unroll
        for (int ai = 0; ai < (THIN_ ? 1 : 2); ++ai)
#pragma unroll
            for (int m = 0; m < 4; ++m) { const int r = (THIN_ ? hs : ai) * 128 + wr * 64 + m * 16 + fr;
                const float gt = gates[(size_t)e * CAP + ml * 256 + r];
                const f32x4 g0 = acc[ai][0][m][0], g1 = acc[ai][0][m][1], u0 = acc[ai][1][m][0], u1 = acc[ai][1][m][1];
                float o[8];
#pragma unroll
                for (int j = 0; j < 4; ++j) { o[j] = silu_f(g0[j]) * u0[j] * gt; o[4 + j] = silu_f(g1[j]) * u1[j] * gt; }
                u32x4 w; w.x = pk2(o[0], o[1]); w.y = pk2(o[2], o[3]); w.z = pk2(o[4], o[5]); w.w = pk2(o[6], o[7]);
                __builtin_amdgcn_raw_buffer_store_b128(w, rs, (int)(((unsigned)(u.pm * 256 + r) * 256u + (unsigned)f0) * 2u), 0, 16); }
    }
};
struct EpiDown {
    static constexpr bool PERM = true, THIN = false;
    bf16_t* Y; const LAS int* toff; const LAS int* cnt;
    DI void operator()(const f32x4 (&acc)[2][2][4][2], const Unit& u, int wr, int wc, int fr, int fq) const {
        const int row0 = u.pm * 256 + wr * 64 + fr, col0 = u.pn * 256 + wc * 32 + 8 * fq;
        const int nvalid = cnt[u.aux] - (u.pm - toff[u.aux]) * 256;
#pragma unroll
        for (int ai = 0; ai < 2; ++ai)
#pragma unroll
            for (int m = 0; m < 4; ++m) { bf16_t* rowp = Y + (size_t)(row0 + ai * 128 + m * 16) * DM + col0;
                if (wr * 64 + fr + ai * 128 + m * 16 >= nvalid) continue;
#pragma unroll
                for (int bj = 0; bj < 2; ++bj) { const f32x4 v0 = acc[ai][bj][m][0], v1 = acc[ai][bj][m][1];
                    u32x4 w; w.x = pk2(v0[0], v0[1]); w.y = pk2(v0[2], v0[3]); w.z = pk2(v1[0], v1[1]); w.w = pk2(v1[2], v1[3]);
                    *(u32x4*)(rowp + bj * 128) = w; } }
    }
};

DI int moe_find(const LAS int* toff, int mt) { return toff[256 + mt]; }
struct MoeGUSched {
    const LAS int* toff; const LAS int* cnt; int T, G, c, halves; const int* tokidx; const char* H; const char* W; unsigned* mtc;
    DI bool next(int i, Unit& u) const { if (i > 0) return false; int L, hs = 0;
        if (!halves) { const int nw = (2 * T < G) ? 2 * T : G; if (c >= nw) return false;
            const int q = nw / pg8::NXCD, r = nw % pg8::NXCD, xcd = c % pg8::NXCD, off = c / pg8::NXCD; L = (xcd < r ? xcd * (q + 1) : r * (q + 1) + (xcd - r) * q) + off; }
        else { const int extra = 2 * T - G; if (extra <= 0 || c >= 2 * extra) return false;
            const int nh = 2 * extra, q = nh / pg8::NXCD, r = nh % pg8::NXCD, xcd = c % pg8::NXCD, off = c / pg8::NXCD, h = (xcd < r ? xcd * (q + 1) : r * (q + 1) + (xcd - r) * q) + off;
            L = G + (h >> 1); hs = h & 1; }
        const int mt = L >> 1; const int e = moe_find(toff, mt);
        u.pm = mt; u.pn = L & 1; u.aux = e | ((mt - toff[e]) << 8) | (hs << 16) | (halves << 17); return true; }
    DI const char* a_ptr(const Unit&) const { return H; }
    DI const char* b_ptr(const Unit& u) const { return W + ((size_t)((u.aux & 0xff) * 512 + u.pn * 256)) * 2048; }
    DI unsigned a_rowoff(const Unit& u, int r) const { const int e = u.aux & 0xff; int slot = ((u.aux >> 8) & 0xff) * 256 + ((u.aux >> 16) & 1) * 128 + r; const int ce = cnt[e]; slot = slot < ce ? slot : ce - 1;
        return (unsigned)tokidx[(size_t)e * CAP + slot] * 2048u; }
    DI void a_ready(const Unit&, int, unsigned) const {}
    DI unsigned early(const Unit&, int) const { return 0u; }
    DI void done(const Unit& u, int tid) const {
        asm volatile("s_waitcnt vmcnt(0)" ::: "memory");
        if ((tid & 63) == 0) (void)__hip_atomic_fetch_add(mtc + 64 * u.pm, ((u.aux >> 17) & 1) ? 1u : 2u, __ATOMIC_RELAXED, __HIP_MEMORY_SCOPE_AGENT);
    }
};
struct MoeDownSched {
    const LAS int* toff; int T, G, c; const char* ACT; const char* W; unsigned* mtc; unsigned* tmo;
    DI bool next(int i, Unit& u) const {
        const int R = (2 * T > G) ? ((2 * (2 * T - G)) < G ? (2 * (2 * T - G)) : G) : 0;
        const int E4 = 4 * ((T < G / 2) ? T : G / 2), n = G - R;
        int j;
        if (n > 0) {
            int ne = 0, pos = 0, lo = c;
            if (c < R) { const int q = R / pg8::NXCD, r = R % pg8::NXCD, x = c % pg8::NXCD, off = c / pg8::NXCD; lo = (x < r ? x * (q + 1) : r * (q + 1) + (x - r) * q) + off; }
            if (c >= R) { const int x = c % pg8::NXCD;
#pragma unroll
                for (int y = 0; y < pg8::NXCD; ++y) if (y < x) pos += (G + 7 - y) / 8 - (R + 7 - y) / 8;
                pos += c / 8 - (R + 7 - x) / 8;
                ne = (pos < E4) ? (E4 - pos + n - 1) / n : 0; lo = R + (n - 1 - pos); }
            j = (i < ne) ? pos + i * n : E4 + lo + (i - ne) * G; }
        else j = c + i * G;
        if (j >= 4 * T) return false;
        const int mt = j >> 2; const int e = moe_find(toff, mt);
        u.pm = mt; u.pn = j & 3; u.aux = e; return true; }
    DI const char* a_ptr(const Unit& u) const { return ACT + (size_t)u.pm * (256 * 512); }
    DI const char* b_ptr(const Unit& u) const { return W + ((size_t)(u.aux * 1024 + u.pn * 256)) * 512; }
    DI unsigned a_rowoff(const Unit&, int r) const { return (unsigned)r * 512u; }
    DI unsigned early(const Unit& u, int tid) const { return (tid < 64) ? __hip_atomic_load(mtc + 64 * u.pm, __ATOMIC_RELAXED, __HIP_MEMORY_SCOPE_AGENT) : 0u; }
    DI void a_ready(const Unit& u, int tid, unsigned erd) const {
        if (tid < 64) {
            unsigned spins = 0;
            while ((unsigned)__builtin_amdgcn_readfirstlane((int)erd) < 32u && (unsigned)__builtin_amdgcn_readfirstlane((int)__hip_atomic_load(mtc + 64 * u.pm, __ATOMIC_RELAXED, __HIP_MEMORY_SCOPE_AGENT)) < 32u) {
                __builtin_amdgcn_s_sleep(2);
                if (++spins > (1u << 20)) { if (tid == 0) __hip_atomic_store(tmo, 1u, __ATOMIC_RELAXED, __HIP_MEMORY_SCOPE_AGENT); break; } }
            __builtin_amdgcn_fence(__ATOMIC_ACQUIRE, "agent");
            asm volatile("s_waitcnt vmcnt(0)" ::: "memory");
        }
        asm volatile("" ::: "memory"); __builtin_amdgcn_s_barrier(); asm volatile("" ::: "memory");
    }
    DI void done(const Unit&, int) const {}
};
DI int moe_tables(unsigned* ctl, int L, LAS int* toff, LAS int* cntl, int tid) {
    if (tid < 64) {
        const int c = (tid < NEXP) ? (int)xb_ld(ctl + CW_CNT + 64 * L + (tid & 31)) : 0;
        const int tl = (c + 255) >> 8;
        int incl = tl;
#pragma unroll
        for (int o = 1; o < 32; o <<= 1) { const int v = __builtin_amdgcn_ds_bpermute((tid - o) << 2, incl); if (tid >= o) incl += v; }
        if (tid < NEXP) { cntl[tid] = c; toff[tid] = incl - tl;
#pragma unroll 1
            for (int ml = 0; ml < tl; ++ml) toff[256 + incl - tl + ml] = tid; }
        if (tid == NEXP - 1) toff[NEXP] = incl;
    }
    __syncthreads();
    return toff[NEXP];
}

DI void cvt_item(const float* src, int ldn, int nvalid, bf16_t* dst, int ldk, LAS float* scr, int lane) {
#pragma unroll 8
    for (int i = 0; i < 32; ++i) { const int kk = 2 * i + (lane >> 5); scr[kk * 33 + (lane & 31)] = __builtin_nontemporal_load(src + (size_t)kk * ldn + (lane & 31)); }
    LDS_WAIT(); asm volatile("" ::: "memory");
    const int c = lane & 7;
    const __amdgpu_buffer_rsrc_t drs = __builtin_amdgcn_make_buffer_rsrc(dst, 0, 0x7fffffff, 0x00020000);
#pragma unroll
    for (int j = 0; j < 4; ++j) { const int n = (lane >> 3) + 8 * j; const LAS float* s = scr + (8 * c) * 33 + n;
        u32x4 o; o.x = pk2(s[0 * 33], s[1 * 33]); o.y = pk2(s[2 * 33], s[3 * 33]); o.z = pk2(s[4 * 33], s[5 * 33]); o.w = pk2(s[6 * 33], s[7 * 33]);
        if (n < nvalid) __builtin_amdgcn_raw_buffer_store_b128(o, drs, (int)(((unsigned)n * (unsigned)ldk + 8u * (unsigned)c) * 2u), 0, 16); }
    LDS_WAIT(); asm volatile("" ::: "memory");
}
DI void cvt_moe_item(const Params& p, unsigned char* ws, int le, int r, LAS float* scr, int lane) {
    bf16_t* wgu = (bf16_t*)(ws + WS_WGU); bf16_t* wdn = (bf16_t*)(ws + WS_WDN);
    if (r < 256) { const bool up = r >= 128; r &= 127; const int kb = r >> 3, nb = r & 7;
        const float* src = (up ? p.w_up : p.w_gate) + ((size_t)le * 1024 + kb * 64) * 256 + nb * 32;
        const int drow = (nb >> 2) * 256 + (up ? 128 : 0) + (nb & 3) * 32;
        cvt_item(src, 256, 32, wgu + ((size_t)le * 512 + drow) * 1024 + kb * 64, 1024, scr, lane);
    } else { r -= 256; const int kb = r >> 5, nb = r & 31;
        const float* src = p.w_down + ((size_t)le * 256 + kb * 64) * 1024 + nb * 32;
        cvt_item(src, 1024, 32, wdn + ((size_t)le * 1024 + nb * 32) * 256 + kb * 64, 256, scr, lane); }
}
DI void p0_prologue(const Params& p, LAS unsigned char* lds, int G, int bid) {
    const int tid = opaque_tid(), lane = tid & 63, wave = __builtin_amdgcn_readfirstlane(tid >> 6);
    unsigned char* ws = opaque_ws(p.ws);
    LAS float* scr = (LAS float*)(lds + wave * 16384);
    const int gw = bid * 8 + wave, NGW = G * 8;
    constexpr int I_MOE = 4 * 32 * 384, I_WIN = 2 * 16 * 71, I_WO = 2 * 16 * 32, I_KV = 2 * 2 * 4, I_POOL = 2 * 4 * 4 * 8;
    constexpr int NITEMS = I_MOE + I_WIN + I_WO + I_KV + I_POOL;
    bf16_t* win = (bf16_t*)(ws + WS_WIN); bf16_t* wo = (bf16_t*)(ws + WS_WO);
    bf16_t* wkv = (bf16_t*)(ws + WS_WKV); bf16_t* wpl = (bf16_t*)(ws + WS_WPOOL);
    for (int it = gw; it < NITEMS; it += NGW) {
        int r = it;
        if (r < I_MOE) { cvt_moe_item(p, ws, 127 - r / 384, r % 384, scr, lane); continue; }
        r -= I_MOE;
        if (r < I_WIN) {
            const int j = r / (16 * 71); r -= j * (16 * 71); const int kb = r / 71, cb = r % 71;
            int sc, dr, nv = 32;
            if (cb < 16) { sc = cb * 32; dr = PC_Q + cb * 32; }
            else if (cb < 20) { sc = 512 + (cb - 16) * 32; dr = PC_KVL + (cb - 16) * 32; }
            else if (cb < 36) { sc = 640 + (cb - 20) * 32; dr = PC_QI + (cb - 20) * 32; }
            else if (cb < 38) { sc = 1152 + (cb - 36) * 32; dr = PC_KI + (cb - 36) * 32; }
            else if (cb < 39) { sc = 1216; dr = PC_WI; nv = 8; }
            else if (cb < 55) { sc = 1224 + (cb - 39) * 32; dr = PC_U + (cb - 39) * 32; }
            else { sc = 1736 + (cb - 55) * 32; dr = PC_V + (cb - 55) * 32; }
            cvt_item(p.w_in + ((size_t)j * 1024 + kb * 64) * DIN + sc, DIN, nv, win + ((size_t)j * DINP + dr) * 1024 + kb * 64, 1024, scr, lane);
            continue; }
        r -= I_WIN;
        if (r < I_WO) { const int j = r / 512; r -= j * 512; const int kb = r >> 5, nb = r & 31;
            cvt_item(p.w_o + ((size_t)j * 1024 + kb * 64) * 1024 + nb * 32, 1024, 32, wo + ((size_t)j * 1024 + nb * 32) * 1024 + kb * 64, 1024, scr, lane);
            continue; }
        r -= I_WO;
        if (r < I_KV) { const int j = r >> 3; r &= 7; const int kb = r >> 2, nb = r & 3;
            cvt_item(p.w_kv_up + ((size_t)j * 128 + kb * 64) * 128 + nb * 32, 128, 32, wkv + ((size_t)j * 128 + nb * 32) * 128 + kb * 64, 128, scr, lane);
            continue; }
        r -= I_KV;
        { const int jg = r >> 5; r &= 31; const int kb = r >> 3, nb = r & 7;
            cvt_item(p.w_pool + ((size_t)jg * 256 + kb * 64) * 256 + nb * 32, 256, 32, wpl + ((size_t)jg * 256 + nb * 32) * 256 + kb * 64, 256, scr, lane); }
    }
    {
        const int gt = bid * 512 + tid, NGT = G * 512;
        bf16_t* wsb = (bf16_t*)(ws + WS_WS);
        for (int i = gt; i < 2 * 4 * 128 * 128; i += NGT) { const int jj = i & 127, ii = (i >> 7) & 127; const float v = ((jj >> 6) <= (ii >> 6)) ? p.w_s[i] : 0.f; wsb[i] = (bf16_t)(pk2(v, 0.f) & 0xffffu); }
        bf16_t* wrh = (bf16_t*)(ws + WS_WR); bf16_t* wrl = wrh + 4 * 48 * 1024;
        for (int i = gt; i < 4 * 48 * 1024; i += NGT) { const int k = i & 1023, n = (i >> 10) % 48, l = i / (48 * 1024);
            float w = 0.f; if (n < 4) w = p.w_gr[((size_t)l * 1024 + k) * 4 + n]; else if (n < 36) w = p.w_er[((size_t)l * 1024 + k) * 32 + (n - 4)];
            const unsigned hi = pk2(w, 0.f) & 0xffffu; const float rem = w - bflo(hi);
            wrh[i] = (bf16_t)hi; wrl[i] = (bf16_t)(pk2(rem, 0.f) & 0xffffu); }
    }
    __syncthreads();
    {
        LAS float* cs = (LAS float*)lds;
        LAS float* red = (LAS float*)(lds + 32768);
        float* mod = (float*)(ws + WS_MOD);
        if (bid < 256) { for (int i = tid; i < 8 * 1024; i += 512) { const float v = p.c[i]; cs[i] = v / (1.0f + __expf(-v)); } }
        __syncthreads();
        for (int u = bid; u < 256; u += G) {
            const int l = u >> 6, n0 = (u & 63) * 96, q = tid & 31, kg = tid >> 5;
            f32x4 acc[8];
#pragma unroll
            for (int b = 0; b < 8; ++b) acc[b] = (f32x4){0.f, 0.f, 0.f, 0.f};
            const float* wp = p.w_mod + ((size_t)l * 1024 + kg * 64) * 6144 + n0 + 4 * q;
            if (q < 24)
#pragma unroll 8
            for (int kk = 0; kk < 64; ++kk) { const f32x4 w = __builtin_nontemporal_load((const f32x4*)(wp + (size_t)kk * 6144));
#pragma unroll
                for (int b = 0; b < 8; ++b) acc[b] += cs[b * 1024 + kg * 64 + kk] * w; }
#pragma unroll
            for (int b = 0; b < 8; ++b) *(LAS f32x4*)(red + (kg * 8 + b) * 128 + 4 * q) = acc[b];
            __syncthreads();
#pragma unroll
            for (int o2 = 0; o2 < 2; ++o2) { const int o = tid * 2 + o2, b = o >> 7, cc = o & 127;
                if (cc < 96) { float s = p.b_mod[(size_t)l * 6144 + n0 + cc];
#pragma unroll
                    for (int k2 = 0; k2 < 16; ++k2) s += red[(k2 * 8 + b) * 128 + cc];
                    mod[((size_t)l * 8 + b) * 6144 + n0 + cc] = s; } }
            __syncthreads();
        }
    }
}

template <int MODE>
DI void norm_rows(const Params& p, int L, const float* xin32  , const xh_t* xin, xh_t* xout, const bool add, const LAS int* toff, int G, int bid, unsigned* nrc = nullptr) {
    const int tid = opaque_tid(), lane = tid & 63, wave = __builtin_amdgcn_readfirstlane(tid >> 6);
    unsigned char* ws = opaque_ws(p.ws);
    const float* mod = (const float*)(ws + WS_MOD);
    const unsigned* tokmeta = (const unsigned*)(ws + WS_TOKMETA);
    const bf16_t* ymoe = (const bf16_t*)(ws + WS_YMOE);
    bf16_t* hb = (bf16_t*)(ws + WS_H);
    float* rstdb = (float*)(ws + WS_RSTD);
    const int NGW = G * 8, RPW = (MTOK + NGW - 1) / NGW, rbeg = (bid * 8 + wave) * RPW, rend = (rbeg + RPW) < MTOK ? (rbeg + RPW) : MTOK;
    if (rbeg >= rend) return;
    struct RowOps { f32x4 xf[4]; h16x8 xh[2]; u32x4 y1[2], y2[2]; };
    RowOps opA, opB;
    unsigned tm = 0u;
    if (add && lane < 2 * (rend - rbeg)) tm = tokmeta[rbeg * 2 + lane];
    asm volatile("" : "+v"(tm));
#define NR_COL(k) (8 * lane + 512 * ((k) >> 1) + 4 * ((k) & 1))
    auto issue = [&](RowOps& o, int ROW) {
        if (xin32) { const float* xr_ = xin32 + (size_t)ROW * DM;
#pragma unroll
            for (int k = 0; k < 4; ++k) o.xf[k] = __builtin_nontemporal_load((const f32x4*)(xr_ + NR_COL(k))); }
        else { const xh_t* xr_ = xin + (size_t)ROW * DM + 8 * lane;
#pragma unroll
            for (int j = 0; j < 2; ++j) o.xh[j] = *(const h16x8*)(xr_ + 512 * j); }
        if (add) { const int kk = ROW - rbeg;
            const unsigned M1 = (unsigned)__builtin_amdgcn_readlane((int)tm, 2 * kk), M2 = (unsigned)__builtin_amdgcn_readlane((int)tm, 2 * kk + 1);
            const int p1_ = toff[M1 >> 16] * 256 + (int)(M1 & 0xffffu), p2_ = toff[M2 >> 16] * 256 + (int)(M2 & 0xffffu);
            const bf16_t* a_ = ymoe + (size_t)p1_ * DM + 8 * lane; const bf16_t* c_ = ymoe + (size_t)p2_ * DM + 8 * lane;
#pragma unroll
            for (int j = 0; j < 2; ++j) { o.y1[j] = *(const u32x4*)(a_ + 512 * j); o.y2[j] = *(const u32x4*)(c_ + 512 * j); } } };
    int bcur = -1;
    f32x4 gfv[4], Gv[4], Sv[4];
    auto proc = [&](RowOps& o, const int row, const int nrow) {
        const int b = row >> 11;
        if (b != bcur) { bcur = b;
            if (add) { const float* gf = mod + ((size_t)(L - 1) * 8 + b) * 6144 + 5120;
#pragma unroll
                for (int k = 0; k < 4; ++k) gfv[k] = *(const f32x4*)(gf + NR_COL(k)); }
            if (MODE == 0) { const float* nw = p.norm_mix + (size_t)L * DM;
                const float* sh = mod + ((size_t)L * 8 + b) * 6144; const float* sc = mod + ((size_t)L * 8 + b) * 6144 + 1024;
#pragma unroll
                for (int k = 0; k < 4; ++k) { Gv[k] = *(const f32x4*)(nw + NR_COL(k)) * (*(const f32x4*)(sc + NR_COL(k)) + 1.0f); Sv[k] = *(const f32x4*)(sh + NR_COL(k)); } }
            if (MODE == 3) { const float* nw = p.norm_out;
#pragma unroll
                for (int k = 0; k < 4; ++k) Gv[k] = *(const f32x4*)(nw + NR_COL(k)); } }
        f32x4 v[4];
#pragma unroll
        for (int k = 0; k < 4; ++k) {
            if (xin32) v[k] = o.xf[k];
            else { const h16x8 w = o.xh[k >> 1]; const h16x4 hh = (k & 1) ? __builtin_shufflevector(w, w, 4, 5, 6, 7) : __builtin_shufflevector(w, w, 0, 1, 2, 3); v[k] = __builtin_convertvector(hh, f32x4); }
            if (add) { const u32x4 a4 = o.y1[k >> 1], c4 = o.y2[k >> 1]; const unsigned a0 = (k & 1) ? a4.z : a4.x, a1 = (k & 1) ? a4.w : a4.y, c0 = (k & 1) ? c4.z : c4.x, c1 = (k & 1) ? c4.w : c4.y;
                const f32x4 g = gfv[k];
                v[k].x += g.x * (bflo(a0) + bflo(c0)); v[k].y += g.y * (bfhi(a0) + bfhi(c0)); v[k].z += g.z * (bflo(a1) + bflo(c1)); v[k].w += g.w * (bfhi(a1) + bfhi(c1)); } }
        if (nrow >= 0) issue(o, nrow);
        if (MODE != 3) {
            const __amdgpu_buffer_rsrc_t xrs = __builtin_amdgcn_make_buffer_rsrc(xout, 0, 0x7fffffff, 0x00020000);
#pragma unroll
            for (int j = 0; j < 2; ++j) { const h16x4 h0 = __builtin_convertvector(v[2 * j], h16x4), h1 = __builtin_convertvector(v[2 * j + 1], h16x4);
                const u32x2 w0 = __builtin_bit_cast(u32x2, h0), w1 = __builtin_bit_cast(u32x2, h1); const u32x4 w = {w0.x, w0.y, w1.x, w1.y};
                if (MODE == 1) __builtin_amdgcn_raw_buffer_store_b128(w, xrs, (int)(((unsigned)row * (unsigned)DM + (unsigned)(8 * lane + 512 * j)) * 2u), 0, 16);
                else *(u32x4*)(xout + (size_t)row * DM + 8 * lane + 512 * j) = w;
                v[2 * j] = __builtin_convertvector(h0, f32x4); v[2 * j + 1] = __builtin_convertvector(h1, f32x4); } }
        float ss = 0.f;
#pragma unroll
        for (int k = 0; k < 4; ++k) ss += (v[k].x * v[k].x + v[k].y * v[k].y) + (v[k].z * v[k].z + v[k].w * v[k].w);
        const float rstd = rsqrtf(wave_sum(ss, lane) * (1.0f / DM) + EPS);
        if (MODE == 0) {
#pragma unroll
            for (int j = 0; j < 2; ++j) { const f32x4 ha = v[2 * j] * rstd * Gv[2 * j] + Sv[2 * j], hb2 = v[2 * j + 1] * rstd * Gv[2 * j + 1] + Sv[2 * j + 1];
                u32x4 o; o.x = pk2(ha.x, ha.y); o.y = pk2(ha.z, ha.w); o.z = pk2(hb2.x, hb2.y); o.w = pk2(hb2.z, hb2.w);
                *(u32x4*)(hb + (size_t)row * DM + 8 * lane + 512 * j) = o; }
        } else if (MODE == 1) {
            if (lane == 0) __hip_atomic_store(rstdb + row, rstd, __ATOMIC_RELAXED, __HIP_MEMORY_SCOPE_AGENT);
        } else {
            float* oo = p.out + (size_t)row * DM;
#pragma unroll
            for (int k = 0; k < 4; ++k) __builtin_nontemporal_store(v[k] * rstd * Gv[k], (f32x4*)(oo + NR_COL(k)));
        }
    };
    issue(opA, rbeg);
    if (rbeg + 1 < rend) issue(opB, rbeg + 1);
#pragma unroll 1
    for (int row = rbeg; row < rend; row += 2) {
        proc(opA, row, (row + 2 < rend) ? row + 2 : -1);
        if (row + 1 < rend) proc(opB, row + 1, (row + 3 < rend) ? row + 3 : -1);
    }
#undef NR_COL
    if (MODE == 1) {
        asm volatile("s_waitcnt vmcnt(0)" ::: "memory");
        if (lane == 0) (void)__hip_atomic_fetch_add(nrc + 64 * (rbeg >> 6), 1u, __ATOMIC_RELAXED, __HIP_MEMORY_SCOPE_AGENT); }
}

template <int WIN>
DI void pool_rows(const xh_t* x, const float* rstdb, const float* gn  , const float* scm  , bf16_t* yo, int row0, int col) {
    const __amdgpu_buffer_rsrc_t yrs = __builtin_amdgcn_make_buffer_rsrc(yo, 0, 0x7fffffff, 0x00020000);
    const int seq0 = row0 & ~(SEQ - 1);
    const f32x4 G4 = *(const f32x4*)(gn + col) * (*(const f32x4*)(scm + col) + 1.0f);
    f32x4 ring[WIN]; f32x4 S = (f32x4){0.f, 0.f, 0.f, 0.f};
#pragma unroll
    for (int i = 0; i < WIN; ++i) ring[i] = (f32x4){0.f, 0.f, 0.f, 0.f};
#pragma unroll
    for (int i = 0; i < 32 + WIN - 1; ++i) {
        const int row = row0 - (WIN - 1) + i;
        const int rowc = row >= seq0 ? row : seq0;
        f32x4 z = ldx4(x + (size_t)rowc * DM + col) * rstdb[rowc];
        if (row < seq0) z = (f32x4){0.f, 0.f, 0.f, 0.f};
        S = S + z - ring[i % WIN]; ring[i % WIN] = z;
        if (i >= WIN - 1) { const int t = row - seq0; const float inv = 1.0f / (float)((t + 1) < WIN ? (t + 1) : WIN);
            const f32x4 y = (S * inv - z) * G4; u32x2 o; o.x = pk2(y.x, y.y); o.y = pk2(y.z, y.w);
            __builtin_amdgcn_raw_buffer_store_b64(o, yrs, (int)(((unsigned)row * (unsigned)DM + (unsigned)col) * 2u), 0, 16); }
    }
}

DI void norm2_phase(const Params& p, LAS unsigned char* lds, int L, int cidx, xh_t* x, int G, int bid) {
    const int tid = opaque_tid(), lane = tid & 63, wave = __builtin_amdgcn_readfirstlane(tid >> 6);
    unsigned char* ws = opaque_ws(p.ws);
    unsigned* ctl = (unsigned*)(ws + WS_CTL);
    const float* mod = (const float*)(ws + WS_MOD);
    bf16_t* hb = (bf16_t*)(ws + WS_H); const bf16_t* yb = (const bf16_t*)(ws + WS_YBUF);
    const bf16_t* wrh = (const bf16_t*)(ws + WS_WR) + (size_t)L * 48 * 1024; const bf16_t* wrl = wrh + 4 * 48 * 1024;
    unsigned* tokmeta = (unsigned*)(ws + WS_TOKMETA); int* tokidx = (int*)(ws + WS_TOKIDX); float* gates = (float*)(ws + WS_GATES);
    constexpr int HP = 1028;
    LAS float* Hf = (LAS float*)lds;
    LAS float* part = (LAS float*)(lds + 16 * HP * 4);
    LAS float* GS = (LAS float*)(lds + 16 * HP * 4 + 8 * 16 * 48 * 4);
    LAS int* dec = (LAS int*)(lds + 16 * HP * 4 + 8 * 16 * 48 * 4 + 8192);
    LAS float* lgt = (LAS float*)(lds + 16 * HP * 4 + 8 * 16 * 48 * 4 + 8192 + 2048);
    LAS float* lgt64 = (LAS float*)(lds + 104448);
    LAS int* hist = (LAS int*)(lds + TAB_OFF + 512); LAS int* base = (LAS int*)(lds + TAB_OFF + 768);
    const int r = lane & 15, g = lane >> 4;
    bf16x8 wh[4][3], wl[4][3];
#pragma unroll
    for (int kk = 0; kk < 4; ++kk)
#pragma unroll
        for (int n = 0; n < 3; ++n) { const size_t wo = (size_t)(n * 16 + r) * 1024 + (wave * 4 + kk) * 32 + g * 8; wh[kk][n] = *(const bf16x8*)(wrh + wo); wl[kk][n] = *(const bf16x8*)(wrl + wo); }
    LAS float* rbias = lgt + 16 * 48;
    if (tid < 48) rbias[tid] = (tid < 4) ? p.b_gr[L * 4 + tid] : (tid < 36) ? p.b_er[L * 32 + tid - 4] : 0.f;
    for (int chunk = bid; chunk < MTOK / 64; chunk += G) {
        const int row0 = chunk * 64, b = row0 >> 11;
        { const float* nw = p.norm_ffn + (size_t)L * DM; const float* sh = mod + ((size_t)L * 8 + b) * 6144 + 3072; const float* sc = sh + 1024;
          for (int i = tid; i < DM; i += 512) { GS[i] = nw[i] * (sc[i] + 1.0f); GS[DM + i] = sh[i]; } }
        if (tid < NEXP) hist[tid] = 0;
        if (tid < 64) { unsigned* xp = ctl + CW_XP + (size_t)(L * 64 + (chunk >> 2)) * 64; unsigned spins = 0;
            while ((unsigned)__builtin_amdgcn_readfirstlane((int)__hip_atomic_load(xp, __ATOMIC_RELAXED, __HIP_MEMORY_SCOPE_AGENT)) < 32u) {
                __builtin_amdgcn_s_sleep(2);
                if (++spins > (1u << 20)) { if (tid == 0) __hip_atomic_store(ctl + CW_TMO, 1u, __ATOMIC_RELAXED, __HIP_MEMORY_SCOPE_AGENT); break; } }
            __builtin_amdgcn_fence(__ATOMIC_ACQUIRE, "agent");
            asm volatile("s_waitcnt vmcnt(0)" ::: "memory"); }
        __syncthreads();
        h16x4 nx[2][4];
#pragma unroll
        for (int rr = 0; rr < 2; ++rr) { const int row = row0 + wave * 2 + rr;
#pragma unroll
            for (int j = 0; j < 4; ++j) nx[rr][j] = *(const h16x4*)(x + (size_t)row * DM + 4 * lane + 256 * j); }
        __syncthreads();
#pragma unroll 1
        for (int pass = 0; pass < 4; ++pass) {
            h16x4 cx[2][4];
#pragma unroll
            for (int rr = 0; rr < 2; ++rr)
#pragma unroll
                for (int j = 0; j < 4; ++j) cx[rr][j] = nx[rr][j];
            if (pass < 3) {
#pragma unroll
                for (int rr = 0; rr < 2; ++rr) { const int row = row0 + (pass + 1) * 16 + wave * 2 + rr;
#pragma unroll
                    for (int j = 0; j < 4; ++j) nx[rr][j] = *(const h16x4*)(x + (size_t)row * DM + 4 * lane + 256 * j); } }
#pragma unroll
            for (int rr = 0; rr < 2; ++rr) { const int lr = wave * 2 + rr, row = row0 + pass * 16 + lr;
                xh_t* xr = x + (size_t)row * DM + 4 * lane;
                f32x4 v[4]; float ss = 0.f;
#pragma unroll
                for (int j = 0; j < 4; ++j) { v[j] = __builtin_convertvector(cx[rr][j], f32x4);
                    ss += (v[j].x * v[j].x + v[j].y * v[j].y) + (v[j].z * v[j].z + v[j].w * v[j].w); }
                const float rstd = rsqrtf(wave_sum(ss, lane) * (1.0f / DM) + EPS);
                const __amdgpu_buffer_rsrc_t hrs2 = __builtin_amdgcn_make_buffer_rsrc(hb, 0, 0x7fffffff, 0x00020000);
#pragma unroll
                for (int j = 0; j < 4; ++j) { const f32x4 Gv = *(const LAS f32x4*)(GS + 4 * lane + 256 * j), Sv = *(const LAS f32x4*)(GS + DM + 4 * lane + 256 * j);
                    const f32x4 h = v[j] * rstd * Gv + Sv;
                    u32x2 o; o.x = pk2(h.x, h.y); o.y = pk2(h.z, h.w); __builtin_amdgcn_raw_buffer_store_b64(o, hrs2, (int)(((unsigned)row * (unsigned)DM + (unsigned)(4 * lane + 256 * j)) * 2u), 0, 16);
                    *(LAS f32x4*)(Hf + lr * HP + 4 * lane + 256 * j) = h; } }
            __syncthreads();
            { f32x4 acc[3];
#pragma unroll
              for (int n = 0; n < 3; ++n) acc[n] = (f32x4){0.f, 0.f, 0.f, 0.f};
#pragma unroll
              for (int kk = 0; kk < 4; ++kk) { const LAS float* hp = Hf + r * HP + (wave * 4 + kk) * 32 + g * 8;
                  const f32x4 h0 = *(const LAS f32x4*)hp, h1 = *(const LAS f32x4*)(hp + 4);
                  u32x4 hi; hi.x = pk2(h0.x, h0.y); hi.y = pk2(h0.z, h0.w); hi.z = pk2(h1.x, h1.y); hi.w = pk2(h1.z, h1.w);
                  u32x4 lo; lo.x = pk2(h0.x - bflo(hi.x), h0.y - bfhi(hi.x)); lo.y = pk2(h0.z - bflo(hi.y), h0.w - bfhi(hi.y));
                  lo.z = pk2(h1.x - bflo(hi.z), h1.y - bfhi(hi.z)); lo.w = pk2(h1.z - bflo(hi.w), h1.w - bfhi(hi.w));
                  const bf16x8 ahi = __builtin_bit_cast(bf16x8, hi), alo = __builtin_bit_cast(bf16x8, lo);
#pragma unroll
                  for (int n = 0; n < 3; ++n) { acc[n] = __builtin_amdgcn_mfma_f32_16x16x32_bf16(ahi, wh[kk][n], acc[n], 0, 0, 0);
                      acc[n] = __builtin_amdgcn_mfma_f32_16x16x32_bf16(ahi, wl[kk][n], acc[n], 0, 0, 0);
                      acc[n] = __builtin_amdgcn_mfma_f32_16x16x32_bf16(alo, wh[kk][n], acc[n], 0, 0, 0); } }
#pragma unroll
              for (int n = 0; n < 3; ++n)
#pragma unroll
                  for (int q = 0; q < 4; ++q) part[(wave * 16 + 4 * g + q) * 48 + n * 16 + r] = acc[n][q]; }
            __syncthreads();
#pragma unroll
            for (int k = 0; k < 2; ++k) { const int idx = tid + 512 * k;
                if (idx < 16 * 48) { float sacc = 0.f;
#pragma unroll
                    for (int w = 0; w < 8; ++w) sacc += part[w * 768 + idx];
                    lgt64[pass * 768 + idx] = sacc + rbias[idx % 48]; } }
        }
        __syncthreads();
        {
            if (tid < 64) {
                const LAS float* lg = lgt64 + tid * 48;
                float gl[4];
#pragma unroll
                for (int i = 0; i < 4; ++i) gl[i] = lg[i];
                int gs = 0; float mx = gl[0];
#pragma unroll
                for (int i = 1; i < 4; ++i) if (gl[i] > mx) { mx = gl[i]; gs = i; }
                float den = 0.f;
#pragma unroll
                for (int i = 0; i < 4; ++i) den += __expf(gl[i] - mx);
                const float pg = 1.0f / den;
                float el[8];
#pragma unroll
                for (int i = 0; i < 8; ++i) el[i] = lg[4 + gs * 8 + i];
                int i1 = 0; float v1 = el[0];
#pragma unroll
                for (int i = 1; i < 8; ++i) if (el[i] > v1) { v1 = el[i]; i1 = i; }
                int i2 = -1; float v2 = 0.f;
#pragma unroll
                for (int i = 0; i < 8; ++i) if (i != i1 && (i2 < 0 || el[i] > v2)) { v2 = el[i]; i2 = i; }
                const float tt = __expf(v2 - v1);
                const float g1 = pg / (1.0f + tt), g2 = pg * tt / (1.0f + tt);
                const int e1 = gs * 8 + i1, e2 = gs * 8 + i2;
                const int rk1 = __hip_atomic_fetch_add(hist + e1, 1, __ATOMIC_RELAXED, __HIP_MEMORY_SCOPE_WORKGROUP), rk2 = __hip_atomic_fetch_add(hist + e2, 1, __ATOMIC_RELAXED, __HIP_MEMORY_SCOPE_WORKGROUP);
                LAS int* d = dec + tid * 6;
                d[0] = e1; d[1] = e2; d[2] = rk1; d[3] = rk2; d[4] = __float_as_int(g1); d[5] = __float_as_int(g2);
            }
        }
        __syncthreads();
        { const int t2 = opaque_tid();
          if (t2 < NEXP) { const int hc = hist[t2]; base[t2] = hc ? (int)xb_add(ctl + CW_CNT + 64 * cidx + t2, (unsigned)hc) : 0; } }
        __syncthreads();
        if (tid < 64) { const LAS int* d = dec + tid * 6; const int row = row0 + tid, e1 = d[0], e2 = d[1];
            const int s1 = base[e1] + d[2], s2 = base[e2] + d[3];
            __hip_atomic_store(tokmeta + row * 2, ((unsigned)e1 << 16) | (unsigned)s1, __ATOMIC_RELAXED, __HIP_MEMORY_SCOPE_AGENT); __hip_atomic_store(tokmeta + row * 2 + 1, ((unsigned)e2 << 16) | (unsigned)s2, __ATOMIC_RELAXED, __HIP_MEMORY_SCOPE_AGENT);
            __hip_atomic_store(tokidx + (size_t)e1 * CAP + s1, row, __ATOMIC_RELAXED, __HIP_MEMORY_SCOPE_AGENT); __hip_atomic_store(tokidx + (size_t)e2 * CAP + s2, row, __ATOMIC_RELAXED, __HIP_MEMORY_SCOPE_AGENT);
            __hip_atomic_store(gates + (size_t)e1 * CAP + s1, __int_as_float(d[4]), __ATOMIC_RELAXED, __HIP_MEMORY_SCOPE_AGENT); __hip_atomic_store(gates + (size_t)e2 * CAP + s2, __int_as_float(d[5]), __ATOMIC_RELAXED, __HIP_MEMORY_SCOPE_AGENT); }
        __syncthreads();
    }
}

DI void kv_tile(const Params& p, unsigned char* ws, int j2, int tile, int lane) {
    const bf16_t* proj = (const bf16_t*)(ws + WS_PROJ); const bf16_t* wkv = (const bf16_t*)(ws + WS_WKV) + (size_t)j2 * 128 * 128;
    bf16_t* Kb = (bf16_t*)(ws + WS_K);
    const int r = lane & 15, g = lane >> 4, row = tile * 16 + r;
    const bf16_t* xr = proj + (size_t)row * DINP + PC_KVL + g * 8;
    float xv[4][8]; float ss = 0.f;
#pragma unroll
    for (int ks = 0; ks < 4; ++ks) { const u32x4 raw = *(const u32x4*)(xr + ks * 32);
        xv[ks][0] = bflo(raw.x); xv[ks][1] = bfhi(raw.x); xv[ks][2] = bflo(raw.y); xv[ks][3] = bfhi(raw.y); xv[ks][4] = bflo(raw.z); xv[ks][5] = bfhi(raw.z); xv[ks][6] = bflo(raw.w); xv[ks][7] = bfhi(raw.w);
#pragma unroll
        for (int i = 0; i < 8; ++i) ss += xv[ks][i] * xv[ks][i]; }
    ss += shx(ss, 16, lane); ss += shx(ss, 32, lane);
    const float rstd = rsqrtf(ss * (1.0f / 128.0f) + EPS);
    bf16x8 af[4];
#pragma unroll
    for (int ks = 0; ks < 4; ++ks) { const float* gn = p.kv_norm + (size_t)j2 * 128 + ks * 32 + g * 8; const f32x4 n0 = *(const f32x4*)gn, n1 = *(const f32x4*)(gn + 4);
        u32x4 w; w.x = pk2(xv[ks][0] * rstd * n0.x, xv[ks][1] * rstd * n0.y); w.y = pk2(xv[ks][2] * rstd * n0.z, xv[ks][3] * rstd * n0.w);
        w.z = pk2(xv[ks][4] * rstd * n1.x, xv[ks][5] * rstd * n1.y); w.w = pk2(xv[ks][6] * rstd * n1.z, xv[ks][7] * rstd * n1.w);
        af[ks] = __builtin_bit_cast(bf16x8, w); }
#pragma unroll
    for (int nt = 0; nt < 8; ++nt) {
        const bf16_t* wr_ = wkv + (size_t)(nt * 16 + r) * 128 + g * 8;
        f32x4 acc = (f32x4){0.f, 0.f, 0.f, 0.f};
#pragma unroll
        for (int ks = 0; ks < 4; ++ks) acc = __builtin_amdgcn_mfma_f32_16x16x32_bf16(*(const bf16x8*)(wr_ + ks * 32), af[ks], acc, 0, 0, 0);
        u32x2 o; o.x = pk2(acc[0], acc[1]); o.y = pk2(acc[2], acc[3]);
        *(u32x2*)(Kb + (size_t)row * 128 + nt * 16 + 4 * g) = o;
    }
}
struct SguOps { bf16x8 wf[4]; u32x2 uu[8]; f32x4 gn[8]; float bias; };
DI void sgu_load_ops(const Params& p, const bf16_t* proj, const bf16_t* wsb, int j2, int gch, int r0, int wave, int r, int g, int nks, SguOps& o) {
    const bf16_t* wrow = wsb + ((size_t)(j2 * 4 + gch) * 128 + wave * 16 + r) * 128 + g * 8;
#pragma unroll
    for (int ks = 0; ks < 4; ++ks) o.wf[ks] = *(const bf16x8*)(wrow + (ks < nks ? ks : 0) * 32);
    const int ii = wave * 16 + r; o.bias = p.b_s[(size_t)(j2 * 4 + gch) * 128 + ii];
    const bf16_t* urow = proj + (size_t)(r0 + ii) * DINP + PC_U + gch * 128 + 4 * g; const float* gp = p.sgu_norm + (size_t)j2 * 512 + gch * 128 + 4 * g;
#pragma unroll
    for (int ct = 0; ct < 8; ++ct) { o.uu[ct] = *(const u32x2*)(urow + ct * 16); o.gn[ct] = *(const f32x4*)(gp + ct * 16); }
}
DI void sgu_mix_store(const LAS bf16_t* vT, bf16_t* cat, int gch, int r0, int wave, int r, int g, int nks, const SguOps& o) {
    constexpr int VP = 136;
    f32x4 acc[8];
#pragma unroll
    for (int ct = 0; ct < 8; ++ct) acc[ct] = (f32x4){0.f, 0.f, 0.f, 0.f};
#pragma unroll
    for (int ks = 0; ks < 4; ++ks) if (ks < nks) {
#pragma unroll
        for (int ct = 0; ct < 8; ++ct) { const bf16x8 vf = *(const LAS bf16x8*)(vT + (ct * 16 + r) * VP + ks * 32 + g * 8);
            acc[ct] = __builtin_amdgcn_mfma_f32_16x16x32_bf16(vf, o.wf[ks], acc[ct], 0, 0, 0); } }
    bf16_t* orow = cat + (size_t)(r0 + wave * 16 + r) * DM + 512 + gch * 128 + 4 * g;
#pragma unroll
    for (int ct = 0; ct < 8; ++ct) { const f32x4 m = acc[ct] * o.gn[ct] + o.bias;
        u32x2 w; w.x = pk2(bflo(o.uu[ct].x) * m[0], bfhi(o.uu[ct].x) * m[1]); w.y = pk2(bflo(o.uu[ct].y) * m[2], bfhi(o.uu[ct].y) * m[3]);
        *(u32x2*)(orow + ct * 16) = w; }
}
DI void sgu_unit(const Params& p, unsigned char* ws, LAS unsigned char* lds, int j2, int unit) {
    const int tid = opaque_tid(), lane = tid & 63, wave = __builtin_amdgcn_readfirstlane(tid >> 6);
    const bf16_t* proj = (const bf16_t*)(ws + WS_PROJ); bf16_t* cat = (bf16_t*)(ws + WS_CAT);
    const bf16_t* wsb = (const bf16_t*)(ws + WS_WS);
    const int gch0 = (unit & 1) * 2, bn = unit >> 1;
    const int r0 = bn * 128;
    constexpr int VP = 136;
    LAS bf16_t* vT = (LAS bf16_t*)lds;
    const int r = lane & 15, g = lane >> 4;
    u32x4 raw[16];
    { const bf16_t* vp = proj + (size_t)(r0 + wave * 16 + g) * DINP + PC_V + r * 8;
#pragma unroll
      for (int it = 0; it < 16; ++it) raw[it] = *(const u32x4*)(vp + (size_t)((it >> 2) * 4) * DINP + (((it & 3) + gch0) & 3) * 128); }
    const int nks = (wave < 4) ? 2 : 4;
    SguOps oa; sgu_load_ops(p, proj, wsb, j2, gch0, r0, wave, r, g, nks, oa);
    float mean[4], rs[4];
#pragma unroll
    for (int rg = 0; rg < 4; ++rg) { float s1 = 0.f, s2 = 0.f;
#pragma unroll
        for (int q = 0; q < 4; ++q) { const u32x4 w = raw[rg * 4 + q];
            const float f0 = bflo(w.x), f1 = bfhi(w.x), f2 = bflo(w.y), f3 = bfhi(w.y), f4 = bflo(w.z), f5 = bfhi(w.z), f6 = bflo(w.w), f7 = bfhi(w.w);
            s1 += ((f0 + f1) + (f2 + f3)) + ((f4 + f5) + (f6 + f7));
            s2 += ((f0 * f0 + f1 * f1) + (f2 * f2 + f3 * f3)) + ((f4 * f4 + f5 * f5) + (f6 * f6 + f7 * f7)); }
#pragma unroll
        for (int o = 1; o < 16; o <<= 1) { s1 += shx(s1, o, lane); s2 += shx(s2, o, lane); }
        mean[rg] = s1 * (1.0f / 512.0f); rs[rg] = rsqrtf(fmaxf(s2 * (1.0f / 512.0f) - mean[rg] * mean[rg], 0.f) + EPS); }
#pragma unroll
    for (int gi = 0; gi < 2; ++gi)
#pragma unroll
        for (int rg = 0; rg < 4; ++rg) { u32x4 w = raw[rg * 4 + gi];
            asm volatile("" : "+v"(w));
            const float f[8] = {bflo(w.x), bfhi(w.x), bflo(w.y), bfhi(w.y), bflo(w.z), bfhi(w.z), bflo(w.w), bfhi(w.w)};
            const int jr = wave * 16 + rg * 4 + g;
#pragma unroll
            for (int e = 0; e < 8; ++e) vT[gi * (128 * VP) + (r * 8 + e) * VP + jr] = (bf16_t)(pk2((f[e] - mean[rg]) * rs[rg], 0.f) & 0xffffu); }
    __syncthreads();
    SguOps ob; sgu_load_ops(p, proj, wsb, j2, gch0 + 1, r0, wave, r, g, nks, ob);
    sgu_mix_store(vT, cat, gch0, r0, wave, r, g, nks, oa);
    sgu_mix_store(vT + 128 * VP, cat, gch0 + 1, r0, wave, r, g, nks, ob);
    __syncthreads();
}

DI unsigned okey(float f) { const unsigned u = __float_as_uint(f); return u ^ ((unsigned)((int)u >> 31) | 0x80000000u); }
DI int cnt_ge8(unsigned k0, unsigned k1, unsigned k2, unsigned k3, unsigned k4, unsigned k5, unsigned k6, unsigned k7, unsigned cand) {
    int c, t1, t2, t3, t4, t5, t6, t7; unsigned long long m0, m1, m2, m3, m4, m5, m6, m7;
    asm("v_cmp_ge_u32_e64 %8, %16, %24\n\tv_cmp_ge_u32_e64 %9, %17, %24\n\tv_cmp_ge_u32_e64 %10, %18, %24\n\tv_cmp_ge_u32_e64 %11, %19, %24\n\t"
        "v_cmp_ge_u32_e64 %12, %20, %24\n\tv_cmp_ge_u32_e64 %13, %21, %24\n\tv_cmp_ge_u32_e64 %14, %22, %24\n\tv_cmp_ge_u32_e64 %15, %23, %24\n\t"
        "s_bcnt1_i32_b64 %0, %8\n\ts_bcnt1_i32_b64 %1, %9\n\ts_bcnt1_i32_b64 %2, %10\n\ts_bcnt1_i32_b64 %3, %11\n\t"
        "s_bcnt1_i32_b64 %4, %12\n\ts_bcnt1_i32_b64 %5, %13\n\ts_bcnt1_i32_b64 %6, %14\n\ts_bcnt1_i32_b64 %7, %15\n\t"
        "s_add_i32 %0, %0, %1\n\ts_add_i32 %2, %2, %3\n\ts_add_i32 %4, %4, %5\n\ts_add_i32 %6, %6, %7\n\ts_add_i32 %0, %0, %2\n\ts_add_i32 %4, %4, %6\n\ts_add_i32 %0, %0, %4"
        : "=&s"(c), "=&s"(t1), "=&s"(t2), "=&s"(t3), "=&s"(t4), "=&s"(t5), "=&s"(t6), "=&s"(t7),
          "=&s"(m0), "=&s"(m1), "=&s"(m2), "=&s"(m3), "=&s"(m4), "=&s"(m5), "=&s"(m6), "=&s"(m7)
        : "v"(k0), "v"(k1), "v"(k2), "v"(k3), "v"(k4), "v"(k5), "v"(k6), "v"(k7), "v"(cand)
        : "scc");
    return c;
}
template <int NS, class IdxF>
DI void topk_search_write(const unsigned (&key)[NS], LAS unsigned short* il, int lane, const IdxF& IDX, unsigned lo) {
    unsigned prefix = 0u;
#pragma unroll 1
    for (int bit = 31; bit >= 0; --bit) {
        const unsigned cand = prefix | (1u << bit);
        if (cand <= lo) { prefix = cand; continue; }
        int cnt = 0;
#pragma unroll
        for (int i0 = 0; i0 < NS; i0 += 8)
            cnt += cnt_ge8(key[i0], key[i0 + 1], key[i0 + 2], key[i0 + 3], key[i0 + 4], key[i0 + 5], key[i0 + 6], key[i0 + 7], cand);
        if (cnt >= 256) prefix = cand;
        if (cnt == 256) break;
    }
    int cgt = 0;
#pragma unroll
    for (int i = 0; i < NS; ++i) cgt += __builtin_popcountll(__ballot(key[i] > prefix));
    int rem = 256 - cgt, wpos = 0;
    const unsigned long long ltmask = (1ull << lane) - 1ull;
#pragma unroll
    for (int i = 0; i < NS; ++i) {
        const bool tie = (key[i] == prefix);
        const unsigned long long tb = __ballot(tie);
        const int before = __builtin_popcountll(tb & ltmask);
        const bool sel = (key[i] > prefix) || (tie && before < rem);
        rem -= __builtin_popcountll(tb);
        const unsigned long long sb = __ballot(sel);
        if (sel) il[wpos + __builtin_popcountll(sb & ltmask)] = (unsigned short)IDX(i);
        wpos += __builtin_popcountll(sb);
    }
}
template <int NS>
DI void select_topk(LAS float* srow, int nsl, LAS unsigned short* il, int lane) {
    unsigned key[NS];
#pragma unroll
    for (int i = 0; i < NS; ++i) key[i] = (i < nsl) ? okey(srow[i * 64 + lane]) : 0u;
    if (NS >= 16) {
        const int nk = nsl * 64; int r0 = (64 * 320 + nk - 1) / nk + 2; r0 = r0 > 64 ? 64 : r0;
        unsigned t0 = 0u;
#pragma unroll 1
        for (int bit = 31; bit >= 12; --bit) { const unsigned cand = t0 | (1u << bit); if (__builtin_popcountll(__ballot(key[0] >= cand)) >= r0) t0 = cand; }
        int cnt0 = 0;
#pragma unroll
        for (int i0 = 0; i0 < NS; i0 += 8) cnt0 += cnt_ge8(key[i0], key[i0 + 1], key[i0 + 2], key[i0 + 3], key[i0 + 4], key[i0 + 5], key[i0 + 6], key[i0 + 7], t0);
        if (cnt0 >= 256 && cnt0 <= 512) {
            LAS unsigned* ck = (LAS unsigned*)srow; LAS unsigned* ci = ck + 1024;
            const unsigned long long ltmask = (1ull << lane) - 1ull; int wpos = 0;
            asm volatile("s_waitcnt lgkmcnt(0)" ::: "memory");
#pragma unroll
            for (int i = 0; i < NS; ++i) { const bool c = key[i] >= t0; const unsigned long long cb = __ballot(c);
                if (c) { const int pos = wpos + __builtin_popcountll(cb & ltmask); ck[pos] = key[i]; ci[pos] = (unsigned)(i * 64 + lane); }
                wpos += __builtin_popcountll(cb); }
            asm volatile("s_waitcnt lgkmcnt(0)" ::: "memory");
            unsigned k8[8], i8[8];
#pragma unroll
            for (int j = 0; j < 8; ++j) { const bool v = (j * 64 + lane) < cnt0; k8[j] = v ? ck[j * 64 + lane] : 0u; i8[j] = v ? ci[j * 64 + lane] : 0u; }
            topk_search_write<8>(k8, il, lane, [&](int j) { return i8[j]; }, t0);
            return;
        }
    }
    topk_search_write<NS>(key, il, lane, [&](int i) { return (unsigned)(i * 64 + lane); }, 0u);
}
template <int NT>
DI void attn_query(const bf16_t* proj, const char* KVb, bf16_t* cat, LAS unsigned char* vbuf, const LAS unsigned short* il, int b, int tq, int lane) {
    constexpr int W = NT * 16, NCH = NT / 4;
    const int r = lane & 15, g = lane >> 4, hh = r & 7, tok = b * SEQ + tq;
    const float slope2 = __builtin_amdgcn_exp2f(-(float)(hh + 1)) * LOG2E;
    const float QS = 0.125f * LOG2E;
    asm volatile("s_waitcnt lgkmcnt(0)" ::: "memory");
#pragma unroll
    for (int c = 0; c < 2; ++c) if (c < NCH)
#pragma unroll
        for (int i = 0; i < 8; ++i) { const int rr = lane >> 3; const int key = il[c * 64 + i * 8 + rr];
            const char* gp = KVb + (size_t)key * 256 + 128 + (((lane & 7) ^ ((rr >> 1) & 3)) << 4);
            __builtin_amdgcn_global_load_lds((const unsigned*)gp, (LAS unsigned*)(vbuf + c * 8192 + i * 1024), 16, 0, 0); }
    bf16x8 qf[2];
    { const bf16_t* qrow = proj + (size_t)tok * DINP + PC_Q + hh * 64 + g * 8;
#pragma unroll
      for (int ks = 0; ks < 2; ++ks) { const u32x4 raw = *(const u32x4*)(qrow + ks * 32); u32x4 w;
        w.x = pk2(bflo(raw.x) * QS, bfhi(raw.x) * QS); w.y = pk2(bflo(raw.y) * QS, bfhi(raw.y) * QS); w.z = pk2(bflo(raw.z) * QS, bfhi(raw.z) * QS); w.w = pk2(bflo(raw.w) * QS, bfhi(raw.w) * QS);
        qf[ks] = __builtin_bit_cast(bf16x8, w); } }
    f32x4 st[NT];
#pragma unroll
    for (int hb = 0; hb < NT; hb += 8) {
        bf16x8 kf[8][2];
#pragma unroll
        for (int t8 = 0; t8 < 8; ++t8) if (hb + t8 < NT) { const int key = il[(hb + t8) * 16 + r];
            const char* kp = KVb + (size_t)key * 256 + g * 16; kf[t8][0] = *(const bf16x8*)kp; kf[t8][1] = *(const bf16x8*)(kp + 64); }
#pragma unroll
        for (int t8 = 0; t8 < 8; ++t8) if (hb + t8 < NT) {
            st[hb + t8] = __builtin_amdgcn_mfma_f32_16x16x32_bf16(kf[t8][0], qf[0], (f32x4){0.f, 0.f, 0.f, 0.f}, 0, 0, 0);
            st[hb + t8] = __builtin_amdgcn_mfma_f32_16x16x32_bf16(kf[t8][1], qf[1], st[hb + t8], 0, 0, 0); }
    }
    const float qpos = (float)tq;
    float mx = -INFINITY;
#pragma unroll
    for (int tt = 0; tt < NT; ++tt) { const u32x2 kk = *(const LAS u32x2*)(il + tt * 16 + 4 * g);
        const float k0 = (float)(kk.x & 0xffffu), k1 = (float)(kk.x >> 16), k2 = (float)(kk.y & 0xffffu), k3 = (float)(kk.y >> 16);
        st[tt][0] -= slope2 * fabsf(qpos - k0); st[tt][1] -= slope2 * fabsf(qpos - k1); st[tt][2] -= slope2 * fabsf(qpos - k2); st[tt][3] -= slope2 * fabsf(qpos - k3);
        mx = fmaxf(fmaxf(mx, fmaxf(st[tt][0], st[tt][1])), fmaxf(st[tt][2], st[tt][3])); }
    mx = fmaxf(mx, shx(mx, 16, lane)); mx = fmaxf(mx, shx(mx, 32, lane));
    float lsum = 0.f;
    bf16x8 pf[NT / 2];
#pragma unroll
    for (int T = 0; T < NT / 2; ++T) { float e[8];
#pragma unroll
        for (int j = 0; j < 4; ++j) { e[j] = __builtin_amdgcn_exp2f(st[2 * T][j] - mx); e[4 + j] = __builtin_amdgcn_exp2f(st[2 * T + 1][j] - mx); }
        lsum += ((e[0] + e[1]) + (e[2] + e[3])) + ((e[4] + e[5]) + (e[6] + e[7]));
        u32x4 pw; pw.x = pk2(e[0], e[1]); pw.y = pk2(e[2], e[3]); pw.z = pk2(e[4], e[5]); pw.w = pk2(e[6], e[7]);
        pf[T] = __builtin_bit_cast(bf16x8, pw); }
    lsum += shx(lsum, 16, lane); lsum += shx(lsum, 32, lane);
    f32x4 o[4];
#pragma unroll
    for (int dt = 0; dt < 4; ++dt) o[dt] = (f32x4){0.f, 0.f, 0.f, 0.f};
    const int tq_ = (r >> 2), tp_ = (r & 3);
    const LAS unsigned char* vbase[4];
    { const int k0_ = 4 * g + tq_;
#pragma unroll
      for (int dt = 0; dt < 4; ++dt) vbase[dt] = vbuf + (k0_ >> 3) * 1024 + (k0_ & 7) * 128 + (((dt * 2 + (tp_ >> 1)) ^ (((k0_ & 7) >> 1) & 3)) << 4) + (tp_ & 1) * 8; }
#pragma unroll
    for (int half = 0; half < 2; ++half) if (half * 2 < NCH) {
        if (half == 1) {
            asm volatile("s_waitcnt lgkmcnt(0)" ::: "memory");
#pragma unroll
            for (int c = 0; c < 2; ++c) if (2 + c < NCH)
#pragma unroll
                for (int i = 0; i < 8; ++i) { const int rr = lane >> 3; const int key = il[(2 + c) * 64 + i * 8 + rr];
                    const char* gp = KVb + (size_t)key * 256 + 128 + (((lane & 7) ^ ((rr >> 1) & 3)) << 4);
                    __builtin_amdgcn_global_load_lds((const unsigned*)gp, (LAS unsigned*)(vbuf + c * 8192 + i * 1024), 16, 0, 0); }
        }
        asm volatile("s_waitcnt vmcnt(0)" ::: "memory");
#pragma unroll
        for (int c = 0; c < 2; ++c) if (half * 2 + c < NCH)
#pragma unroll
            for (int pr = 0; pr < 2; ++pr) { const int T = (half * 2 + c) * 2 + pr;
#pragma unroll
                for (int dt = 0; dt < 4; ++dt) {
                    const LAS unsigned char* a1 = vbase[dt] + c * 8192 + pr * 4096;
                    const s16x4 v1 = __builtin_amdgcn_ds_read_tr16_b64_v4i16((LAS s16x4*)a1), v2 = __builtin_amdgcn_ds_read_tr16_b64_v4i16((LAS s16x4*)(a1 + 2048));
                    const bf16x8 vf = {v1[0], v1[1], v1[2], v1[3], v2[0], v2[1], v2[2], v2[3]};
                    o[dt] = __builtin_amdgcn_mfma_f32_16x16x32_bf16(vf, pf[T], o[dt], 0, 0, 0); } }
    }
    const float inv = 1.0f / lsum;
    if (r < 8) { const __amdgpu_buffer_rsrc_t crs = __builtin_amdgcn_make_buffer_rsrc(cat, 0, 0x7fffffff, 0x00020000);
        const unsigned ob = ((unsigned)tok * (unsigned)DM + (unsigned)(r * 64 + 4 * g)) * 2u;
#pragma unroll
        for (int dt = 0; dt < 4; ++dt) { u32x2 ov; ov.x = pk2(o[dt][0] * inv, o[dt][1] * inv); ov.y = pk2(o[dt][2] * inv, o[dt][3] * inv); __builtin_amdgcn_raw_buffer_store_b64(ov, crs, (int)(ob + dt * 32u), 0, 16); } }
}
DI void attn16_vdma(const char* KVb, LAS unsigned char* vbuf, const LAS unsigned short* il, int chunk, int buf, int lane) {
#pragma unroll
    for (int i = 0; i < 8; ++i) { const int rr = lane >> 3; const int key = il[chunk * 64 + i * 8 + rr];
        const char* gp = KVb + (size_t)key * 256 + 128 + (((lane & 7) ^ ((rr >> 1) & 3)) << 4);
        __builtin_amdgcn_global_load_lds((const unsigned*)gp, (LAS unsigned*)(vbuf + buf * 8192 + i * 1024), 16, 0, 0); }
}
DI void attn16_loadq(const bf16_t* proj, int tok, u32x4 (&qraw)[2], int lane) {
    const int r = lane & 15, g = lane >> 4, hh = r & 7;
    const bf16_t* qrow = proj + (size_t)tok * DINP + PC_Q + hh * 64 + g * 8;
    qraw[0] = *(const u32x4*)qrow; qraw[1] = *(const u32x4*)(qrow + 32);
}
DI void attn16_load(const char* KVb, const LAS unsigned short* il, bf16x8 (&kf)[16][2], int lane) {
#pragma unroll
    for (int tt = 0; tt < 16; ++tt)
#pragma unroll
        for (int i = 0; i < 2; ++i) { const int key = il[tt * 16 + 8 * i + (lane >> 3)];
            kf[tt][i] = *(const bf16x8*)(KVb + (size_t)key * 256 + (lane & 7) * 16); }
}
DI void attn16_kfrag(LAS unsigned char* stg, const bf16x8 (&raw)[2], bf16x8 (&fr)[2], int lane) {
    const int r = lane & 15, g = lane >> 4;
#pragma unroll
    for (int i = 0; i < 2; ++i) { const int rr = 8 * i + (lane >> 3); *(LAS bf16x8*)(stg + rr * 128 + (((lane & 7) ^ (rr & 7)) << 4)) = raw[i]; }
#pragma unroll
    for (int ks = 0; ks < 2; ++ks) fr[ks] = *(const LAS bf16x8*)(stg + r * 128 + (((ks * 4 + g) ^ (r & 7)) << 4));
}
DI void attn16_compute(const bf16_t* proj, const char* KVb, bf16_t* cat, LAS unsigned char* vbuf, LAS unsigned char* kstg, const LAS unsigned short* il, int b, int tq, bf16x8 (&kf)[16][2], u32x4 (&qraw)[2],
                       const LAS unsigned short* nil, int ntok, int lane) {
    const int r = lane & 15, g = lane >> 4, hh = r & 7, tok = b * SEQ + tq;
    const float slope2 = __builtin_amdgcn_exp2f(-(float)(hh + 1)) * LOG2E;
    const float QS = 0.125f * LOG2E;
    bf16x8 qf[2];
#pragma unroll
    for (int ks = 0; ks < 2; ++ks) { const u32x4 raw = qraw[ks]; u32x4 w;
        w.x = pk2(bflo(raw.x) * QS, bfhi(raw.x) * QS); w.y = pk2(bflo(raw.y) * QS, bfhi(raw.y) * QS); w.z = pk2(bflo(raw.z) * QS, bfhi(raw.z) * QS); w.w = pk2(bflo(raw.w) * QS, bfhi(raw.w) * QS);
        qf[ks] = __builtin_bit_cast(bf16x8, w); }
    f32x4 st[16];
#pragma unroll
    for (int tt = 0; tt < 16; ++tt) { bf16x8 fr[2]; attn16_kfrag(kstg, kf[tt], fr, lane);
        st[tt] = __builtin_amdgcn_mfma_f32_16x16x32_bf16(fr[0], qf[0], (f32x4){0.f, 0.f, 0.f, 0.f}, 0, 0, 0);
        st[tt] = __builtin_amdgcn_mfma_f32_16x16x32_bf16(fr[1], qf[1], st[tt], 0, 0, 0); }
    if (nil) attn16_load(KVb, nil, kf, lane);
    const float qpos = (float)tq;
    float mx = -INFINITY;
#pragma unroll
    for (int tt = 0; tt < 16; ++tt) { const u32x2 kk = *(const LAS u32x2*)(il + tt * 16 + 4 * g);
        const float k0 = (float)(kk.x & 0xffffu), k1 = (float)(kk.x >> 16), k2 = (float)(kk.y & 0xffffu), k3 = (float)(kk.y >> 16);
        st[tt][0] -= slope2 * fabsf(qpos - k0); st[tt][1] -= slope2 * fabsf(qpos - k1); st[tt][2] -= slope2 * fabsf(qpos - k2); st[tt][3] -= slope2 * fabsf(qpos - k3);
        mx = fmaxf(fmaxf(mx, fmaxf(st[tt][0], st[tt][1])), fmaxf(st[tt][2], st[tt][3])); }
    mx = fmaxf(mx, shx(mx, 16, lane)); mx = fmaxf(mx, shx(mx, 32, lane));
    float lsum = 0.f;
    bf16x8 pf[8];
#pragma unroll
    for (int T = 0; T < 8; ++T) { float e[8];
#pragma unroll
        for (int j = 0; j < 4; ++j) { e[j] = __builtin_amdgcn_exp2f(st[2 * T][j] - mx); e[4 + j] = __builtin_amdgcn_exp2f(st[2 * T + 1][j] - mx); }
        lsum += ((e[0] + e[1]) + (e[2] + e[3])) + ((e[4] + e[5]) + (e[6] + e[7]));
        u32x4 pw; pw.x = pk2(e[0], e[1]); pw.y = pk2(e[2], e[3]); pw.z = pk2(e[4], e[5]); pw.w = pk2(e[6], e[7]);
        pf[T] = __builtin_bit_cast(bf16x8, pw); }
    lsum += shx(lsum, 16, lane); lsum += shx(lsum, 32, lane);
    if (nil) attn16_loadq(proj, ntok, qraw, lane);
    f32x4 o[4];
#pragma unroll
    for (int dt = 0; dt < 4; ++dt) o[dt] = (f32x4){0.f, 0.f, 0.f, 0.f};
    const int tq_ = (r >> 2), tp_ = (r & 3);
    const LAS unsigned char* vbase[4];
    { const int k0_ = 4 * g + tq_;
#pragma unroll
      for (int dt = 0; dt < 4; ++dt) vbase[dt] = vbuf + (k0_ >> 3) * 1024 + (k0_ & 7) * 128 + (((dt * 2 + (tp_ >> 1)) ^ (((k0_ & 7) >> 1) & 3)) << 4) + (tp_ & 1) * 8; }
#pragma unroll
    for (int half = 0; half < 2; ++half) {
        if (half == 1) {
            asm volatile("s_waitcnt lgkmcnt(0)" ::: "memory");
            attn16_vdma(KVb, vbuf, il, 2, 0, lane); attn16_vdma(KVb, vbuf, il, 3, 1, lane);
        }
        asm volatile("s_waitcnt vmcnt(0)" ::: "memory");
#pragma unroll
        for (int c = 0; c < 2; ++c)
#pragma unroll
            for (int pr = 0; pr < 2; ++pr) { const int T = (half * 2 + c) * 2 + pr;
#pragma unroll
                for (int dt = 0; dt < 4; ++dt) {
                    const LAS unsigned char* a1 = vbase[dt] + c * 8192 + pr * 4096;
                    const s16x4 v1 = __builtin_amdgcn_ds_read_tr16_b64_v4i16((LAS s16x4*)a1), v2 = __builtin_amdgcn_ds_read_tr16_b64_v4i16((LAS s16x4*)(a1 + 2048));
                    const bf16x8 vf = {v1[0], v1[1], v1[2], v1[3], v2[0], v2[1], v2[2], v2[3]};
                    o[dt] = __builtin_amdgcn_mfma_f32_16x16x32_bf16(vf, pf[T], o[dt], 0, 0, 0); } }
    }
    const float inv = 1.0f / lsum;
    if (r < 8) { const __amdgpu_buffer_rsrc_t crs = __builtin_amdgcn_make_buffer_rsrc(cat, 0, 0x7fffffff, 0x00020000);
        const unsigned ob = ((unsigned)tok * (unsigned)DM + (unsigned)(r * 64 + 4 * g)) * 2u;
#pragma unroll
        for (int dt = 0; dt < 4; ++dt) { u32x2 ov; ov.x = pk2(o[dt][0] * inv, o[dt][1] * inv); ov.y = pk2(o[dt][2] * inv, o[dt][3] * inv); __builtin_amdgcn_raw_buffer_store_b64(ov, crs, (int)(ob + dt * 32u), 0, 16); } }
}
DI void attn_unit(const Params& p, unsigned char* ws, LAS unsigned char* lds, int b, int qt, unsigned* qctr, int qadd, volatile LAS int* qslot, unsigned* pnl) {
    const int tid = opaque_tid(); int lane = tid & 63; const int wave = __builtin_amdgcn_readfirstlane(tid >> 6);
    int qnext = 0;
    if (tid == 0) qnext = (int)__hip_atomic_fetch_add(qctr, 1u, __ATOMIC_RELAXED, __HIP_MEMORY_SCOPE_AGENT) + qadd;
    const bf16_t* proj = (const bf16_t*)(ws + WS_PROJ); const bf16_t* Kb = (const bf16_t*)(ws + WS_K);
    bf16_t* cat = (bf16_t*)(ws + WS_CAT);
    const int r = lane & 15, g = lane >> 4;
    const int t0 = qt * 16, nk = ((t0 >> 6) + 1) * 64, tok0 = b * SEQ + t0;
    LAS float* sc = (LAS float*)lds;
    for (int rep_ = 0; rep_ < ((PROBE_MASK & (1 << 12)) ? 2 : 1); ++rep_)
    if (nk > 256) {
        const bf16_t* qrow = proj + (size_t)(tok0 + r) * DINP;
        bf16x8 qf[8][2]; float wv[8];
#pragma unroll
        for (int h = 0; h < 8; ++h)
#pragma unroll
            for (int ks = 0; ks < 2; ++ks) qf[h][ks] = *(const bf16x8*)(qrow + PC_QI + h * 64 + ks * 32 + g * 8);
        { const u32x4 wr_ = *(const u32x4*)(qrow + PC_WI); const float C = 0.35355339059f * 0.125f;
          wv[0] = bflo(wr_.x) * C; wv[1] = bfhi(wr_.x) * C; wv[2] = bflo(wr_.y) * C; wv[3] = bfhi(wr_.y) * C; wv[4] = bflo(wr_.z) * C; wv[5] = bfhi(wr_.z) * C; wv[6] = bflo(wr_.w) * C; wv[7] = bfhi(wr_.w) * C; }
        const bf16_t* kbase = proj + (size_t)(b * SEQ + r) * DINP + PC_KI + g * 8;
        bf16x8 kn0 = *(const bf16x8*)(kbase + (size_t)(wave * 16) * DINP), kn1 = *(const bf16x8*)(kbase + (size_t)(wave * 16) * DINP + 32);
        for (int kt = wave; kt < nk / 16; kt += 8) {
            const bf16x8 k0 = kn0, k1 = kn1;
            { const int ktn = (kt + 8 < nk / 16) ? kt + 8 : kt;
              const bf16_t* krow = kbase + (size_t)(ktn * 16) * DINP; kn0 = *(const bf16x8*)krow; kn1 = *(const bf16x8*)(krow + 32); }
            f32x4 s = (f32x4){0.f, 0.f, 0.f, 0.f};
#pragma unroll
            for (int h = 0; h < 8; ++h) { f32x4 a = __builtin_amdgcn_mfma_f32_16x16x32_bf16(k0, qf[h][0], (f32x4){0.f, 0.f, 0.f, 0.f}, 0, 0, 0);
                a = __builtin_amdgcn_mfma_f32_16x16x32_bf16(k1, qf[h][1], a, 0, 0, 0);
#pragma unroll
                for (int q = 0; q < 4; ++q) s[q] += wv[h] * fmaxf(a[q], 0.f); }
            *(LAS f32x4*)(sc + r * SC_PITCH + kt * 16 + 4 * g) = s;
        }
    }
    if (tid == 0) *qslot = qnext;
    __syncthreads();
    asm volatile("" : "+v"(lane));
    LAS unsigned short* ilw = (LAS unsigned short*)(lds + IDX_OFF) + wave * 512;
    LAS unsigned char* vbuf = lds + wave * (2 * SC_PITCH * 4);
    const char* KVb = (const char*)Kb + (size_t)b * SEQ * 256;
    const int tqa = t0 + wave * 2;
    if (nk > 256) {
        const int nsl = nk >> 6;
        LAS float* srow = sc + (wave * 2) * SC_PITCH;
        bf16x8 kf[16][2]; u32x4 qraw[2];
        LAS unsigned char* kstg = lds + KSTG_OFF + wave * 2048;
#define SELECT(SROW, IL) do { if (nsl <= 8) select_topk<8>(SROW, nsl, IL, lane); else if (nsl <= 16) select_topk<16>(SROW, nsl, IL, lane); \
            else if (nsl <= 24) select_topk<24>(SROW, nsl, IL, lane); else select_topk<32>(SROW, nsl, IL, lane); } while (0)
        SELECT(srow, ilw);
        if (PROBE_MASK & (1 << 13)) { SELECT(srow, ilw); SELECT(srow + SC_PITCH, ilw + 256); }
        LDS_WAIT(); asm volatile("" ::: "memory");
        attn16_loadq(proj, b * SEQ + tqa, qraw, lane); attn16_load(KVb, ilw, kf, lane);
        attn16_vdma(KVb, vbuf, ilw, 0, 0, lane);
        SELECT(srow + SC_PITCH, ilw + 256);
#undef SELECT
        LDS_WAIT(); asm volatile("" ::: "memory");
        attn16_vdma(KVb, vbuf, ilw, 1, 1, lane);
        attn16_compute(proj, KVb, cat, vbuf, kstg, ilw, b, tqa, kf, qraw, (PROBE_MASK & ((1 << 14) | (1 << 18))) ? nullptr : ilw + 256, b * SEQ + tqa + 1, lane);
        asm volatile("s_waitcnt lgkmcnt(0)" ::: "memory");
#pragma unroll 1
        for (int rep_ = 0; rep_ < ((PROBE_MASK & (1 << 14)) ? 2 : 1); ++rep_) {
            if (PROBE_MASK & ((1 << 14) | (1 << 18))) { asm volatile("s_waitcnt lgkmcnt(0)" ::: "memory"); attn16_loadq(proj, b * SEQ + tqa + 1, qraw, lane); attn16_load(KVb, ilw + 256, kf, lane); }
            attn16_vdma(KVb, vbuf, ilw + 256, 0, 0, lane); attn16_vdma(KVb, vbuf, ilw + 256, 1, 1, lane);
            attn16_compute(proj, KVb, cat, vbuf, kstg, ilw + 256, b, tqa + 1, kf, qraw, nullptr, 0, lane); }
        if (PROBE_MASK & ((1 << 19) | (1 << 20))) {
                const LAS unsigned short* ilq = ilw + 256;
#pragma unroll 1
                for (int tt = 0; tt < 16; ++tt) { u32x4 x0, x1;
                    if (PROBE_MASK & (1 << 19)) { const int key = (ilq[tt * 16 + r] + 1024) & 2047; const char* kp = KVb + (size_t)key * 256 + g * 16;
                        x0 = *(const u32x4*)kp; x1 = *(const u32x4*)(kp + 64); }
                    else { const int k0 = (ilq[tt * 16 + (lane >> 3)] + 1024) & 2047, k1 = (ilq[tt * 16 + 8 + (lane >> 3)] + 1024) & 2047;
                        x0 = *(const u32x4*)(KVb + (size_t)k0 * 256 + (lane & 7) * 16); x1 = *(const u32x4*)(KVb + (size_t)k1 * 256 + (lane & 7) * 16); }
                    asm volatile("" :: "v"(x0), "v"(x1)); } }
    } else {
        for (int qq = 0; qq < 2; ++qq) {
            LAS unsigned short* il = ilw + qq * 256;
            for (int k = lane; k < nk; k += 64) il[k] = (unsigned short)k;
        }
        LDS_WAIT(); asm volatile("" ::: "memory");
        for (int qq = 0; qq < 2; ++qq) {
            const LAS unsigned short* il = ilw + qq * 256;
            if (nk == 256) attn_query<16>(proj, KVb, cat, vbuf, il, b, tqa + qq, lane);
            else if (nk == 192) attn_query<12>(proj, KVb, cat, vbuf, il, b, tqa + qq, lane);
            else if (nk == 128) attn_query<8>(proj, KVb, cat, vbuf, il, b, tqa + qq, lane);
            else attn_query<4>(proj, KVb, cat, vbuf, il, b, tqa + qq, lane);
        }
    }
    asm volatile("s_waitcnt vmcnt(0) lgkmcnt(0)" ::: "memory");
    __syncthreads();
    if (tid == 0) (void)__hip_atomic_fetch_add(pnl + 64 * ((b * SEQ + t0) >> 8), 1u, __ATOMIC_RELAXED, __HIP_MEMORY_SCOPE_AGENT);
}

DI void a45_phase(const Params& p, LAS unsigned char* lds, int G, int bid, int call) {
    unsigned char* ws = opaque_ws(p.ws);
    const int b = bid & 7, nb = (G + 7 - b) >> 3;
    unsigned* qctr = (unsigned*)(ws + WS_CTL) + CW_A45Q + (size_t)(call * 8 + b) * 64;
    volatile LAS int* qs = (volatile LAS int*)(lds + QSLOT_OFF);
    int u = bid >> 3, it = 0;
    unsigned* pnl = (unsigned*)(ws + WS_CTL) + CW_PNL + (size_t)call * 64 * 64;
    while (u < 128) { attn_unit(p, ws, lds, b, 127 - u, qctr, nb, qs + (it & 1), pnl); u = __builtin_amdgcn_readfirstlane(qs[it & 1]); ++it; }
}
DI void pool_phase(const Params& p, int L, const xh_t* xcur, int G, int bid) {
    const int tid = opaque_tid(), lane = tid & 63, wave = __builtin_amdgcn_readfirstlane(tid >> 6);
    unsigned char* ws = opaque_ws(p.ws);
    const float* mod = (const float*)(ws + WS_MOD);
    unsigned* ctl = (unsigned*)(ws + WS_CTL); unsigned* nrc = ctl + CW_NR + (size_t)(L >> 1) * 256 * 64; unsigned* plc = ctl + CW_PL + (size_t)(L >> 1) * 256 * 64;
    for (int u = bid * 2 + (wave >> 2); u < MTOK / 32; u += 2 * G) {
        const int row0 = u * 32, col = ((wave & 3) * 64 + lane) * 4, b = row0 >> 11;
        {
          const int ch = row0 >> 6; const bool prev = ((row0 & 63) == 0) && ((row0 & (SEQ - 1)) != 0);
          unsigned spins = 0;
          while ((unsigned)__builtin_amdgcn_readfirstlane((int)__hip_atomic_load(nrc + 64 * ch, __ATOMIC_RELAXED, __HIP_MEMORY_SCOPE_AGENT)) < 8u ||
                 (prev && (unsigned)__builtin_amdgcn_readfirstlane((int)__hip_atomic_load(nrc + 64 * (ch - 1), __ATOMIC_RELAXED, __HIP_MEMORY_SCOPE_AGENT)) < 8u)) {
              __builtin_amdgcn_s_sleep(2);
              if (++spins > (1u << 20)) { if (lane == 0) __hip_atomic_store(ctl + CW_TMO, 1u, __ATOMIC_RELAXED, __HIP_MEMORY_SCOPE_AGENT); break; } }
          __builtin_amdgcn_fence(__ATOMIC_ACQUIRE, "agent");
          asm volatile("s_waitcnt vmcnt(0)" ::: "memory"); }
        const float* gn = p.norm_mix + (size_t)L * DM; const float* scm = mod + ((size_t)L * 8 + b) * 6144 + 1024;
        const float* rs = (const float*)(ws + WS_RSTD); bf16_t* yo = (bf16_t*)(ws + WS_H);
        switch (wave & 3) {
            case 0: pool_rows<2>(xcur, rs, gn, scm, yo, row0, col); break;
            case 1: pool_rows<4>(xcur, rs, gn, scm, yo, row0, col); break;
            case 2: pool_rows<8>(xcur, rs, gn, scm, yo, row0, col); break;
            default: pool_rows<16>(xcur, rs, gn, scm, yo, row0, col); break;
        }
        asm volatile("s_waitcnt vmcnt(0)" ::: "memory");
        if (lane == 0) (void)__hip_atomic_fetch_add(plc + 64 * (row0 >> 6), 1u, __ATOMIC_RELAXED, __HIP_MEMORY_SCOPE_AGENT);
    }
}
DI void gemm_win(const Params& p, LAS unsigned char* lds, int j2, int cidx, int G, int bid) {
    unsigned char* ws = opaque_ws(p.ws);
    pg8::WinSched S; S.init(64, 9, G, bid); S.A = (const char*)(ws + WS_H); S.B = (const char*)(ws + WS_WIN) + (size_t)j2 * DINP * 1024 * 2;
    S.a_tile = 256 * 2048; S.a_pn = 0; S.b_tile = 256 * 2048; S.lda2 = 2048; S.wpc = (unsigned*)(ws + WS_CTL) + CW_WPC + (size_t)cidx * 64 * 64;
    EpiProj E{(bf16_t*)(ws + WS_PROJ)};
    pg8::gemm_phase<EpiProj, pg8::WinSched, false>(lds, 1024, S, E);
}
DI void win_tail(const Params& p, LAS unsigned char* lds, int j2, int cidx, int G, int bid) {
    const int tid = opaque_tid(), lane = tid & 63, wave = __builtin_amdgcn_readfirstlane(tid >> 6);
    unsigned char* ws = opaque_ws(p.ws);
    { pg8::StaticSched S; S.init(64, 9, G, bid); Unit u;
#pragma unroll 1
      for (int i = 0; S.next(i, u); ++i) if (u.pn == 8) {
#pragma unroll 1
          for (int k = 0; k < 2; ++k) kv_tile(p, ws, j2, u.pm * 16 + wave * 2 + k, lane); } }
    const int nunits = 64 * 9, maxu = (nunits + G - 1) / G, R = nunits - (maxu - 1) * G;
    int rank = bid, n = G;
    if (R < G) { if (bid < R) return; rank = bid - R; n = G - R; }
    unsigned* wpc = (unsigned*)(ws + WS_CTL) + CW_WPC + (size_t)cidx * 64 * 64; unsigned* tmo = (unsigned*)(ws + WS_CTL) + CW_TMO;
#pragma unroll 1
    for (int u = rank; u < 256; u += n) {
        const int pm = u >> 2;
        if (tid < 64) { unsigned spins = 0;
            while ((unsigned)__builtin_amdgcn_readfirstlane((int)__hip_atomic_load(wpc + 64 * pm, __ATOMIC_RELAXED, __HIP_MEMORY_SCOPE_AGENT)) < 32u) {
                __builtin_amdgcn_s_sleep(2);
                if (++spins > (1u << 20)) { if (tid == 0) __hip_atomic_store(tmo, 1u, __ATOMIC_RELAXED, __HIP_MEMORY_SCOPE_AGENT); break; } }
            __builtin_amdgcn_fence(__ATOMIC_ACQUIRE, "agent");
            asm volatile("s_waitcnt vmcnt(0)" ::: "memory"); }
        __syncthreads();
        sgu_unit(p, ws, lds, j2, u);
    }
}
DI void gemm_wo(const Params& p, LAS unsigned char* lds, int L, xh_t* xcur, int G, int bid) {
    unsigned char* ws = opaque_ws(p.ws);
    pg8::WoSched S; S.init(64, 4, G, bid); S.A = (const char*)(ws + WS_CAT); S.B = (const char*)(ws + WS_WO) + (size_t)(L >> 1) * 1024 * 1024 * 2;
    S.a_tile = 256 * 2048; S.a_pn = 0; S.b_tile = 256 * 2048; S.lda2 = 2048; S.pnl = (unsigned*)(ws + WS_CTL) + CW_PNL + (size_t)(L >> 1) * 64 * 64; S.tmo = (unsigned*)(ws + WS_CTL) + CW_TMO; S.xp = (unsigned*)(ws + WS_CTL) + CW_XP + (size_t)L * 64 * 64;
    EpiX E{xcur, (const float*)(ws + WS_MOD) + (size_t)L * 8 * 6144 + 2048, nullptr};
    pg8::gemm_phase<EpiX, pg8::WoSched, false>(lds, 1024, S, E);
}
DI void gemm_pool(const Params& p, LAS unsigned char* lds, int L, xh_t* xcur, int G, int bid) {
    unsigned char* ws = opaque_ws(p.ws);
    pg8::PoolSched S; S.init(64, 4, G, bid); S.A = (const char*)(ws + WS_H); S.B = (const char*)(ws + WS_WPOOL) + (size_t)(L >> 1) * 4 * 256 * 256 * 2;
    S.a_tile = 256 * 2048; S.a_pn = 512; S.b_tile = 256 * 512; S.lda2 = 2048; S.xp = (unsigned*)(ws + WS_CTL) + CW_XP + (size_t)L * 64 * 64;
    S.plc = (unsigned*)(ws + WS_CTL) + CW_PL + (size_t)(L >> 1) * 256 * 64; S.tmo = (unsigned*)(ws + WS_CTL) + CW_TMO;
    EpiX E{xcur, (const float*)(ws + WS_MOD) + (size_t)L * 8 * 6144 + 2048, p.pool_scale + (size_t)(L >> 1) * DM};
    pg8::gemm_phase<EpiX, pg8::PoolSched, false>(lds, 256, S, E);
}
template <bool HALVES>
DI void gemm_gu(const Params& p, LAS unsigned char* lds, int L, const LAS int* toff, const LAS int* cntl, int T, int G, int bid) {
    unsigned char* ws = opaque_ws(p.ws);
    MoeGUSched S{toff, cntl, T, G, bid, HALVES ? 1 : 0, (const int*)(ws + WS_TOKIDX), (const char*)(ws + WS_H), (const char*)(ws + WS_WGU) + (size_t)L * 32 * 512 * 1024 * 2,
                 (unsigned*)(ws + WS_CTL) + CW_MTC + (size_t)L * 160 * 64};
    EpiGU<HALVES> E{(bf16_t*)(ws + WS_ACT), (const float*)(ws + WS_GATES)};
    pg8::gemm_phase<EpiGU<HALVES>, MoeGUSched, true>(lds, 1024, S, E);
}
DI void gemm_down(const Params& p, LAS unsigned char* lds, int L, const LAS int* toff, const LAS int* cntl, int T, int G, int bid) {
    unsigned char* ws = opaque_ws(p.ws);
    MoeDownSched S{toff, T, G, bid, (const char*)(ws + WS_ACT), (const char*)(ws + WS_WDN) + (size_t)L * 32 * 1024 * 256 * 2,
                   (unsigned*)(ws + WS_CTL) + CW_MTC + (size_t)L * 160 * 64, (unsigned*)(ws + WS_CTL) + CW_TMO};
    EpiDown E{(bf16_t*)(ws + WS_YMOE), toff, cntl};
    pg8::gemm_phase<EpiDown, MoeDownSched, false>(lds, 256, S, E);
}

#define BARX() do { xcd_barrier(bar); if (PROBE_MASK & (1 << 15)) xcd_barrier(bar); } while (0)
#define RUN(bit, stmt) do { stmt; if (PROBE_MASK & (1 << (bit))) { xcd_barrier(bar); stmt; } } while (0)
__global__ void __launch_bounds__(512, 2) mk_fwd(Params p) {
    extern __shared__ __attribute__((aligned(16))) unsigned char lds_raw[];
    LAS unsigned char* lds = (LAS unsigned char*)lds_raw;
    const int G = gridDim.x, bid = blockIdx.x;
    unsigned* ctl = (unsigned*)(p.ws + WS_CTL);
    volatile LAS unsigned* MISC = (volatile LAS unsigned*)(lds + MISC_OFF);
    if (threadIdx.x < 64) MISC[threadIdx.x] = 0u;
    __syncthreads();
    XcdBarrier bar = xcd_barrier_post(ctl + CW_BAR, MISC + 8);
    LAS int* toff = (LAS int*)(lds + TAB_OFF); LAS int* cntl = (LAS int*)(lds + TAB_OFF + 256);
    xh_t* xb0 = (xh_t*)(p.ws + WS_X0); xh_t* xb1 = (xh_t*)(p.ws + WS_X1);

    RUN(0, p0_prologue(p, lds, G, bid));
    BARX();

#pragma unroll 1
    for (int L = 0; L < 4; ++L) {
        const float* xin32 = (L == 0) ? p.x : nullptr;
        const xh_t* xin = (L & 1) ? xb0 : xb1;
        xh_t* xcur = (L & 1) ? xb1 : xb0;
        if ((L & 1) == 0) {
            RUN(1, norm_rows<0>(p, L, xin32, xin, xcur, L > 0, toff, G, bid));
            BARX();
            if (PROBE_MASK & (1 << 2)) { gemm_win(p, lds, L >> 1, 2 + (L >> 1), G, bid); xcd_barrier(bar); }
            gemm_win(p, lds, L >> 1, L >> 1, G, bid);
            win_tail(p, lds, L >> 1, L >> 1, G, bid);
            BARX();
            a45_phase(p, lds, G, bid, L >> 1);
            gemm_wo(p, lds, L, xcur, G, bid);
        } else {
            norm_rows<1>(p, L, nullptr, xin, xcur, true, toff, G, bid, ctl + CW_NR + (size_t)(L >> 1) * 256 * 64);
            pool_phase(p, L, xcur, G, bid);
            gemm_pool(p, lds, L, xcur, G, bid);
        }
        norm2_phase(p, lds, L, L, xcur, G, bid);
        BARX();
        const int T = moe_tables(ctl, L, toff, cntl, opaque_tid());
        gemm_gu<false>(p, lds, L, toff, cntl, T, G, bid);
        gemm_gu<true>(p, lds, L, toff, cntl, T, G, bid);
        RUN(8, gemm_down(p, lds, L, toff, cntl, T, G, bid));
        BARX();
    }
    RUN(11, norm_rows<3>(p, 4, nullptr, xb1, nullptr, true, toff, G, bid));
}

extern "C" void kernel_launch(void* const* d_in, const int* in_sizes, int n_in, void* d_out, int out_size, void* d_ws, size_t ws_size, hipStream_t stream) {
    static int grid = 0;
    if (grid == 0) {
        if (n_in != 23 || out_size != MTOK * DM || ws_size < WS_END) { fprintf(stderr, "kernel_launch: unexpected shapes (n_in %d out %d ws %zu need %zu)\n", n_in, out_size, ws_size, (size_t)WS_END); grid = -1; return; }
        int dev = 0, cus = 0, per_cu = 0;
        if (hipGetDevice(&dev) != hipSuccess || hipDeviceGetAttribute(&cus, hipDeviceAttributeMultiprocessorCount, dev) != hipSuccess) { grid = -1; return; }
        if (hipFuncSetAttribute((const void*)mk_fwd, hipFuncAttributeMaxDynamicSharedMemorySize, LDS_BYTES) != hipSuccess) { fprintf(stderr, "kernel_launch: hipFuncSetAttribute failed\n"); grid = -1; return; }
        if (hipOccupancyMaxActiveBlocksPerMultiprocessor(&per_cu, (const void*)mk_fwd, 512, LDS_BYTES) != hipSuccess || per_cu < 1)
            fprintf(stderr, "kernel_launch: occupancy query reports %d\n", per_cu);
        (void)hipGetLastError();
        grid = cus < 256 ? cus : 256;
    }
    if (grid < 0) return;
    (void)hipMemsetAsync((char*)d_ws + WS_CTL, 0, CTL_BYTES, stream);
    Params p{};
    const float** f = (const float**)&p;
    for (int i = 0; i < 23; ++i) f[i] = (const float*)d_in[i];
    p.out = (float*)d_out; p.ws = (unsigned char*)d_ws;
    hipLaunchKernelGGL(mk_fwd, dim3(grid), dim3(512), LDS_BYTES, stream, p);
}
```
